# Optimizing an MI355X kernel written in HIP

```python
import math
import jax, jax.numpy as jnp
from jax import lax
import numpy as np

D_MODEL = 1024
BATCH = 2
SEQ = 8192
DEPTH = 2

CHUNK = 64
N_META = 16
N_A_LAYERS = DEPTH // 2
N_B_LAYERS = DEPTH - N_A_LAYERS
GDN_HEADS = 8
GDN_HEAD_DIM = 128
GDN_WIDTH = GDN_HEADS * GDN_HEAD_DIM
CONV_WIDTH = 4
SB_HEADS = 16
SB_HEAD_DIM = 64
SB_WIDTH = SB_HEADS * SB_HEAD_DIM
SB_BLOCK = 128
D_FF = -(-(8 * D_MODEL) // (3 * 256)) * 256
GDN_IN_COLS = 4 * GDN_WIDTH + 2 * GDN_HEADS
EPS = 1e-6

kernel_name = "yoco_gdn_stickbreaking_hybrid"


def rms_norm(x, g):
    xf = x.astype(jnp.float32)
    y = xf * lax.rsqrt(jnp.mean(xf * xf, axis=-1, keepdims=True) + EPS)
    return (y * g.astype(jnp.float32)).astype(x.dtype)


def l2_normalize(x):
    return x * lax.rsqrt(jnp.sum(x * x, axis=-1, keepdims=True) + EPS)


def causal_depthwise_conv(x, w):
    L = x.shape[1]
    xp = jnp.pad(x, ((0, 0), (CONV_WIDTH - 1, 0), (0, 0)))
    return sum(xp[:, i:i + L] * w[i] for i in range(CONV_WIDTH))


def gated_delta_chunked(q, k, v, g, beta):
    b, nh, L, dk = q.shape
    dv = v.shape[-1]
    n = L // CHUNK
    q = q.reshape(b, nh, n, CHUNK, dk) * (dk ** -0.5)
    k = k.reshape(b, nh, n, CHUNK, dk)
    v = v.reshape(b, nh, n, CHUNK, dv)
    g = g.reshape(b, nh, n, CHUNK)
    beta = beta.reshape(b, nh, n, CHUNK)
    G = jnp.cumsum(g, axis=-1)
    incl = jnp.tril(jnp.ones((CHUNK, CHUNK), dtype=bool))
    strict = jnp.tril(jnp.ones((CHUNK, CHUNK), dtype=bool), -1)
    diff = G[..., :, None] - G[..., None, :]
    decay = jnp.where(incl, jnp.exp(jnp.where(incl, diff, 0.0)), 0.0)
    kk = jnp.einsum('bhnid,bhnjd->bhnij', k, k)
    lower = jnp.eye(CHUNK, dtype=q.dtype) + jnp.where(strict, beta[..., :, None] * decay * kk, 0.0)
    rhs = jnp.concatenate([beta[..., None] * v, (beta * jnp.exp(G))[..., None] * k], axis=-1)
    sol = lax.linalg.triangular_solve(lower, rhs, left_side=True, lower=True, unit_diagonal=True)
    u_base = sol[..., :dv]
    w_corr = sol[..., dv:]
    attn = jnp.einsum('bhnid,bhnjd->bhnij', q, k) * decay
    q_dec = q * jnp.exp(G)[..., None]
    g_last = G[..., -1]
    k_dec = k * jnp.exp(g_last[..., None] - G)[..., None]

    def step(S, inp):
        u_b, w_c, a_c, qd, kd, gl = inp
        u = u_b - jnp.einsum('bhcd,bhde->bhce', w_c, S)
        o = jnp.einsum('bhcd,bhde->bhce', qd, S) + jnp.einsum('bhij,bhje->bhie', a_c, u)
        S = S * jnp.exp(gl)[..., None, None] + jnp.einsum('bhcd,bhce->bhde', kd, u)
        return S, o

    xs = tuple(jnp.moveaxis(t, 2, 0) for t in (u_base, w_corr, attn, q_dec, k_dec, g_last))
    S0 = jnp.zeros((b, nh, dk, dv), dtype=q.dtype)
    _, o = lax.scan(step, S0, xs)
    return jnp.moveaxis(o, 0, 2).reshape(b, nh, L, dv)


def gdn_mixer(h, w_in, conv_w, a_log, dt_bias, onorm_g, w_out):
    b, L, _ = h.shape
    proj = h @ w_in
    qkv = jax.nn.silu(causal_depthwise_conv(proj[..., :3 * GDN_WIDTH], conv_w)).astype(jnp.float32)
    gate = proj[..., 3 * GDN_WIDTH:4 * GDN_WIDTH].astype(jnp.float32)
    a_in = proj[..., 4 * GDN_WIDTH:4 * GDN_WIDTH + GDN_HEADS].astype(jnp.float32)
    b_in = proj[..., 4 * GDN_WIDTH + GDN_HEADS:].astype(jnp.float32)
    heads = lambda t: t.reshape(b, L, GDN_HEADS, GDN_HEAD_DIM).transpose(0, 2, 1, 3)
    q = l2_normalize(heads(qkv[..., :GDN_WIDTH]))
    k = l2_normalize(heads(qkv[..., GDN_WIDTH:2 * GDN_WIDTH]))
    v = heads(qkv[..., 2 * GDN_WIDTH:])
    g = (-jnp.exp(a_log.astype(jnp.float32)) * jax.nn.softplus(a_in + dt_bias.astype(jnp.float32))).transpose(0, 2, 1)
    beta = jax.nn.sigmoid(b_in).transpose(0, 2, 1)
    front = (-N_META) % CHUNK
    back = (-(front + L)) % CHUNK
    p4 = ((0, 0), (0, 0), (front, back), (0, 0))
    p3 = ((0, 0), (0, 0), (front, back))
    o = gated_delta_chunked(jnp.pad(q, p4), jnp.pad(k, p4), jnp.pad(v, p4), jnp.pad(g, p3), jnp.pad(beta, p3))
    o = o[:, :, front:front + L].transpose(0, 2, 1, 3)
    o = o * lax.rsqrt(jnp.mean(o * o, axis=-1, keepdims=True) + EPS) * onorm_g.astype(jnp.float32)
    o = o * jax.nn.silu(gate.reshape(b, L, GDN_HEADS, GDN_HEAD_DIM))
    return o.reshape(b, L, GDN_WIDTH).astype(h.dtype) @ w_out


def shared_kv(h, norm_g, w_kv):
    b, L, _ = h.shape
    kv = (rms_norm(h, norm_g) @ w_kv).astype(jnp.float32).reshape(b, L, 2, SB_HEADS, SB_HEAD_DIM)
    return kv[:, :, 0].transpose(0, 2, 1, 3), kv[:, :, 1].transpose(0, 2, 1, 3)


def sb_mixer(h, k_sh, v_sh, w_q, w_o):
    b, L, _ = h.shape
    q = (h @ w_q).astype(jnp.float32).reshape(b, L, SB_HEADS, SB_HEAD_DIM).transpose(0, 2, 1, 3)
    pad = (-L) % SB_BLOCK
    Lp = L + pad
    p4 = ((0, 0), (0, 0), (0, pad), (0, 0))
    q, k, v = jnp.pad(q, p4), jnp.pad(k_sh, p4), jnp.pad(v_sh, p4)
    nb = Lp // SB_BLOCK
    q_blocks = q.reshape(b, SB_HEADS, nb, SB_BLOCK, SB_HEAD_DIM).transpose(2, 0, 1, 3, 4)
    key_pos = jnp.arange(Lp)
    scale = SB_HEAD_DIM ** -0.5

    def one_block(args):
        q_blk, blk = args
        q_pos = blk * SB_BLOCK + jnp.arange(SB_BLOCK)
        visible = key_pos[None, :] < q_pos[:, None]
        z = jnp.einsum('bhqd,bhkd->bhqk', q_blk, k) * scale
        log_beta = jax.nn.log_sigmoid(z)
        log_keep = jnp.where(visible, log_beta - z, 0.0)
        log_w = log_beta + lax.cumsum(log_keep, axis=3, reverse=True) - log_keep
        w = jnp.where(visible, jnp.exp(log_w), 0.0)
        return jnp.einsum('bhqk,bhkd->bhqd', w, v)

    o = lax.map(one_block, (q_blocks, jnp.arange(nb)))
    o = o.transpose(1, 2, 0, 3, 4).reshape(b, SB_HEADS, Lp, SB_HEAD_DIM)[:, :, :L]
    o = o.transpose(0, 2, 1, 3).reshape(b, L, SB_WIDTH).astype(h.dtype)
    return o @ w_o


def swiglu(h, w_gate_up, w_down):
    gu = h @ w_gate_up
    return (jax.nn.silu(gu[..., :D_FF]) * gu[..., D_FF:]) @ w_down


def setup_inputs(seed: int = 0) -> dict:
    key = jax.random.key(seed)
    ks = jax.random.split(key, 20)
    f32 = jnp.float32
    dense = lambda k, shape, fan_in: jax.random.normal(k, shape, f32) * (fan_in ** -0.5)
    gain = lambda k, shape: 1.0 + 0.02 * jax.random.normal(k, shape, f32)
    dt = jnp.exp(jax.random.uniform(ks[5], (N_A_LAYERS, GDN_HEADS), f32, math.log(1e-3), math.log(1e-1)))
    return {
        "x": jax.random.normal(ks[0], (BATCH, SEQ, D_MODEL), f32),
        "meta_tokens": jax.random.normal(ks[1], (N_META, D_MODEL), f32),
        "gdn_norm_g": gain(ks[2], (N_A_LAYERS, D_MODEL)),
        "gdn_w_in": dense(ks[3], (N_A_LAYERS, D_MODEL, GDN_IN_COLS), D_MODEL),
        "gdn_conv_w": dense(ks[4], (N_A_LAYERS, CONV_WIDTH, 3 * GDN_WIDTH), CONV_WIDTH),
        "gdn_a_log": jnp.log(jax.random.uniform(ks[6], (N_A_LAYERS, GDN_HEADS), f32, 1.0, 16.0)),
        "gdn_dt_bias": dt + jnp.log(-jnp.expm1(-dt)),
        "gdn_onorm_g": gain(ks[7], (N_A_LAYERS, GDN_HEAD_DIM)),
        "gdn_w_out": dense(ks[8], (N_A_LAYERS, GDN_WIDTH, D_MODEL), GDN_WIDTH),
        "kv_norm_g": gain(ks[9], (D_MODEL,)),
        "w_kv": dense(ks[10], (D_MODEL, 2 * SB_WIDTH), D_MODEL),
        "sb_norm_g": gain(ks[11], (N_B_LAYERS, D_MODEL)),
        "sb_w_q": dense(ks[12], (N_B_LAYERS, D_MODEL, SB_WIDTH), D_MODEL),
        "sb_w_o": dense(ks[13], (N_B_LAYERS, SB_WIDTH, D_MODEL), SB_WIDTH),
        "ffn_norm_g": gain(ks[14], (DEPTH, D_MODEL)),
        "ffn_w_gate_up": dense(ks[15], (DEPTH, D_MODEL, 2 * D_FF), D_MODEL),
        "ffn_w_down": dense(ks[16], (DEPTH, D_FF, D_MODEL), D_FF),
        "final_norm_g": gain(ks[17], (D_MODEL,)),
    }


def reference(x, meta_tokens, gdn_norm_g, gdn_w_in, gdn_conv_w, gdn_a_log, gdn_dt_bias,
              gdn_onorm_g, gdn_w_out, kv_norm_g, w_kv, sb_norm_g, sb_w_q, sb_w_o,
              ffn_norm_g, ffn_w_gate_up, ffn_w_down, final_norm_g):
    b = x.shape[0]
    meta = jnp.broadcast_to(meta_tokens.astype(x.dtype)[None], (b, N_META, D_MODEL))
    h = jnp.concatenate([meta, x], axis=1)
    k_sh = None
    v_sh = None
    for layer in range(DEPTH):
        if layer < N_A_LAYERS:
            h = h + gdn_mixer(rms_norm(h, gdn_norm_g[layer]), gdn_w_in[layer], gdn_conv_w[layer],
                              gdn_a_log[layer], gdn_dt_bias[layer], gdn_onorm_g[layer], gdn_w_out[layer])
        else:
            j = layer - N_A_LAYERS
            h = h + sb_mixer(rms_norm(h, sb_norm_g[j]), k_sh, v_sh, sb_w_q[j], sb_w_o[j])
        h = h + swiglu(rms_norm(h, ffn_norm_g[layer]), ffn_w_gate_up[layer], ffn_w_down[layer])
        if layer == N_A_LAYERS - 1:
            k_sh, v_sh = shared_kv(h, kv_norm_g, w_kv)
    return rms_norm(h, final_norm_g)[:, N_META:]
```

```cpp
#include <hip/hip_runtime.h>
#include <hip/hip_cooperative_groups.h>
#include <cstdio>
#include <cstdint>
namespace cg = cooperative_groups;
namespace pg8 {
#define PG8_LAS __attribute__((address_space(3)))
typedef unsigned short bf16_t;
typedef short bf16x8 __attribute__((ext_vector_type(8)));
typedef float f32x4 __attribute__((ext_vector_type(4)));
typedef unsigned u32x4 __attribute__((ext_vector_type(4)));
constexpr int BM = 256, BK = 64, HALF = 128, HTB = HALF * BK * 2  , STAGE_BYTES = 8 * HTB, NXCD = 8, WGM = 8;

__host__ __device__ __forceinline__ int lds_byte(int r, int c) { const int st = (r >> 4) * 2 + (c >> 5), rr = r & 15, cc = c & 31, ob = rr * 64 + cc * 2; return st * 1024 + (ob ^ (((ob >> 9) & 1) << 5)); }
__host__ __device__ __forceinline__ void stage_rc(int b, int& R, int& C) { const int st = b / 1024, sb = b % 1024, swz = sb ^ (((sb >> 9) & 1) << 5); R = (st >> 1) * 16 + swz / 64; C = (st & 1) * 32 + (swz % 64) / 2; }
__host__ __device__ __forceinline__ int perm32(int rho) { const int n = rho >> 4, i = rho & 15; return 8 * (i >> 2) + 4 * n + (i & 3); }

struct Unit { int pm, pn; };
struct Gemm { const bf16_t* A; const bf16_t* Bt; int M, N, K; };

struct StaticOrder {
    int nM, nN, nwg, G, c;
    __host__ __device__ void init(int M, int N, int G_, int c_) { nM = M / BM; nN = N / BM; nwg = nM * nN; G = G_; c = c_; }
    __host__ __device__ bool next(int i, Unit& u) const {
        const long L = (long)i * G + c; if (L >= nwg) return false;
        int wgid = (int)L; { const int q = nwg / NXCD, r = nwg % NXCD, xcd = wgid % NXCD, off = wgid / NXCD; wgid = (xcd < r ? xcd * (q + 1) : r * (q + 1) + (xcd - r) * q) + off; }
        const int nig = WGM * nN, gid = wgid / nig, fm = gid * WGM, gsz = (nM - fm) < WGM ? (nM - fm) : WGM;
        u.pm = fm + ((wgid % nig) % gsz); u.pn = (wgid % nig) / gsz; return true;
    }
    __device__ __forceinline__ void a_ready(const Unit&) const {}
    __device__ __forceinline__ void done(const Unit&) const {}
};
template <class Epi, class Sched, bool ALIGN_EPI = false, bool SP2 = false>
__device__ __forceinline__ void gemm_phase(PG8_LAS unsigned char* lds, const Gemm g, const Sched& S, const Epi& E) {
    int tid_raw = threadIdx.x; asm volatile("" : "+v"(tid_raw));
    const int tid = tid_raw, wid = __builtin_amdgcn_readfirstlane(tid >> 6), lane = tid & 63, wr = wid >> 2, wc = wid & 3, fr = lane & 15, fq = lane >> 4;
    const int K = g.K, nt = K / BK;
    unsigned voffA[2], voffB[2];
#pragma unroll
    for (int i = 0; i < 2; ++i) { int R, C; stage_rc(tid * 16 + i * 8192, R, C); const int Rb = Epi::PERM ? ((R & ~31) + perm32(R & 31)) : R;
        voffA[i] = (unsigned)(R * K + C) * 2u; voffB[i] = (unsigned)(Rb * K + C) * 2u; }
    const size_t kstep = (size_t)(BK * 2);
    const size_t hstep = (size_t)HALF * K * 2;
    const size_t tstep = 2 * hstep;
    const unsigned ldsw = (unsigned)wid * 1024u;
    const int aoff = lds_byte(wr * 64 + fr, fq * 8), boff = lds_byte(wc * 32 + fr, fq * 8);
#define PG8_SA(b, h) (((b) * 2 + (h)) * HTB)
#define PG8_SB(b, h) ((4 + (b) * 2 + (h)) * HTB)
#define PG8_STAGE(bufoff, gbase, voff) do { _Pragma("unroll") for (int _i = 0; _i < 2; ++_i) \
        __builtin_amdgcn_global_load_lds((const unsigned*)((const char*)(gbase) + (voff)[_i]), (PG8_LAS unsigned*)(lds + (bufoff) + ldsw + _i * 8192), 16, 0, 0); } while (0)
#define PG8_LDA(dst, b, h) do { _Pragma("unroll") for (int m = 0; m < 4; ++m) _Pragma("unroll") for (int k = 0; k < 2; ++k) dst[m][k] = *(const PG8_LAS bf16x8*)(lds + PG8_SA(b, h) + aoff + m * 2048 + k * 1024); } while (0)
#define PG8_LDB(dst, b, h) do { _Pragma("unroll") for (int n = 0; n < 2; ++n) _Pragma("unroll") for (int k = 0; k < 2; ++k) dst[n][k] = *(const PG8_LAS bf16x8*)(lds + PG8_SB(b, h) + boff + n * 2048 + k * 1024); } while (0)
#define PG8_MMA(ai, bj, At, Bt) do { __builtin_amdgcn_s_setprio(1); _Pragma("unroll") for (int m = 0; m < 4; ++m) _Pragma("unroll") for (int n = 0; n < 2; ++n) _Pragma("unroll") for (int k = 0; k < 2; ++k) \
        acc[ai][bj][m][n] = __builtin_amdgcn_mfma_f32_16x16x32_bf16(Bt[n][k], At[m][k], acc[ai][bj][m][n], 0, 0, 0); __builtin_amdgcn_s_setprio(0); } while (0)
#define PG8_WAIT_V(n) asm volatile("s_waitcnt vmcnt(" #n ")" ::: "memory")
#define PG8_WAIT_L(n) asm volatile("s_waitcnt lgkmcnt(" #n ")" ::: "memory")
#define PG8_BAR __builtin_amdgcn_s_barrier()
#define PG8_SCHED __builtin_amdgcn_sched_barrier(0)
    Unit cur, nxt; int ui = 0;
    if (!S.next(0, cur)) return;
    f32x4 acc[2][2][4][2];
#pragma unroll
    for (int a = 0; a < 2; ++a)
#pragma unroll
        for (int b = 0; b < 2; ++b)
#pragma unroll
            for (int m = 0; m < 4; ++m)
#pragma unroll
                for (int n = 0; n < 2; ++n) acc[a][b][m][n] = (f32x4){0.f, 0.f, 0.f, 0.f};
    bf16x8 At[4][2], B0[2][2], B1[2][2];
    const char* cA = (const char*)g.A + (size_t)cur.pm * tstep; const char* cB = (const char*)g.Bt + (size_t)cur.pn * tstep;
    S.a_ready(cur);
    if constexpr (SP2) {
        PG8_STAGE(PG8_SB(0, 0), cB, voffB); PG8_STAGE(PG8_SB(0, 1), cB + hstep, voffB); PG8_STAGE(PG8_SA(0, 0), cA, voffA); PG8_STAGE(PG8_SA(0, 1), cA + hstep, voffA);
        if (wr == 1) PG8_BAR;
        PG8_WAIT_V(2); PG8_BAR;
        PG8_STAGE(PG8_SB(1, 0), cB + kstep, voffB); PG8_STAGE(PG8_SA(1, 0), cA + kstep, voffA); PG8_STAGE(PG8_SB(1, 1), cB + hstep + kstep, voffB);
        PG8_WAIT_V(6); PG8_BAR;
    } else {
        PG8_STAGE(PG8_SB(0, 0), cB, voffB); PG8_STAGE(PG8_SA(0, 0), cA, voffA); PG8_STAGE(PG8_SB(0, 1), cB + hstep, voffB); PG8_STAGE(PG8_SA(0, 1), cA + hstep, voffA);
        if (wr == 1) PG8_BAR;
        PG8_WAIT_V(4); PG8_BAR;
        PG8_STAGE(PG8_SB(1, 0), cB + kstep, voffB); PG8_STAGE(PG8_SA(1, 0), cA + kstep, voffA); PG8_STAGE(PG8_SB(1, 1), cB + hstep + kstep, voffB);
        PG8_WAIT_V(6); PG8_BAR;
    }
    for (;;) {
        const bool has_next = S.next(ui + 1, nxt);
        const char* nA = has_next ? (const char*)g.A + (size_t)nxt.pm * tstep : cA; const char* nB = has_next ? (const char*)g.Bt + (size_t)nxt.pn * tstep : cB;
        for (int t = 0; t < nt; t += 2) {
            const bool last = (t == nt - 2);
            const char* a1 = cA + (size_t)(t + 1) * kstep;
            const char* a2 = last ? nA : cA + (size_t)(t + 2) * kstep; const char* b2 = last ? nB : cB + (size_t)(t + 2) * kstep;
            const char* a3 = a2 + kstep; const char* b3 = b2 + kstep;
            if (last && has_next) S.a_ready(nxt);
            if constexpr (SP2) {
            PG8_LDB(B0, 0, 0); PG8_LDB(B1, 0, 1); PG8_SCHED; PG8_LDA(At, 0, 0); PG8_STAGE(PG8_SA(1, 1), a1 + hstep, voffA);
            PG8_WAIT_V(8); PG8_WAIT_L(0); PG8_BAR; PG8_MMA(0, 0, At, B0); PG8_MMA(0, 1, At, B1); PG8_BAR; PG8_SCHED;
            PG8_LDA(At, 0, 1); PG8_STAGE(PG8_SB(0, 0), b2, voffB); PG8_STAGE(PG8_SB(0, 1), b2 + hstep, voffB); PG8_STAGE(PG8_SA(0, 0), a2, voffA);
            PG8_WAIT_V(8); PG8_WAIT_L(0); PG8_BAR; PG8_MMA(1, 0, At, B0); PG8_MMA(1, 1, At, B1); PG8_BAR; PG8_SCHED;
            PG8_LDB(B0, 1, 0); PG8_LDB(B1, 1, 1); PG8_SCHED; PG8_LDA(At, 1, 0); PG8_STAGE(PG8_SA(0, 1), a2 + hstep, voffA);
            PG8_WAIT_V(8); PG8_WAIT_L(0); PG8_BAR; PG8_MMA(0, 0, At, B0); PG8_MMA(0, 1, At, B1); PG8_BAR; PG8_SCHED;
            PG8_LDA(At, 1, 1); PG8_STAGE(PG8_SB(1, 0), b3, voffB); PG8_STAGE(PG8_SB(1, 1), b3 + hstep, voffB); PG8_STAGE(PG8_SA(1, 0), a3, voffA);
            PG8_WAIT_V(8); PG8_WAIT_L(0); PG8_BAR; PG8_MMA(1, 0, At, B0); PG8_MMA(1, 1, At, B1); PG8_BAR; PG8_SCHED;
            } else {
            PG8_LDB(B0, 0, 0); PG8_SCHED; PG8_LDA(At, 0, 0); PG8_STAGE(PG8_SA(1, 1), a1 + hstep, voffA);
            PG8_WAIT_L(8); PG8_BAR; PG8_WAIT_L(0); PG8_MMA(0, 0, At, B0); PG8_BAR; PG8_SCHED;
            PG8_LDB(B1, 0, 1); PG8_STAGE(PG8_SB(0, 0), b2, voffB);
            PG8_BAR; PG8_WAIT_L(0); PG8_MMA(0, 1, At, B1); PG8_BAR;
            PG8_LDA(At, 0, 1); PG8_STAGE(PG8_SA(0, 0), a2, voffA);
            PG8_BAR; PG8_WAIT_L(0); PG8_MMA(1, 0, At, B0); PG8_BAR; PG8_SCHED;
            PG8_STAGE(PG8_SB(0, 1), b2 + hstep, voffB);
            PG8_WAIT_V(6); PG8_BAR; PG8_MMA(1, 1, At, B1); PG8_BAR;
            PG8_LDB(B0, 1, 0); PG8_SCHED; PG8_LDA(At, 1, 0); PG8_STAGE(PG8_SA(0, 1), a2 + hstep, voffA);
            PG8_WAIT_L(8); PG8_BAR; PG8_WAIT_L(0); PG8_MMA(0, 0, At, B0); PG8_BAR; PG8_SCHED;
            PG8_LDB(B1, 1, 1); PG8_STAGE(PG8_SB(1, 0), b3, voffB);
            PG8_BAR; PG8_WAIT_L(0); PG8_MMA(0, 1, At, B1); PG8_BAR;
            PG8_LDA(At, 1, 1); PG8_STAGE(PG8_SA(1, 0), a3, voffA);
            PG8_BAR; PG8_WAIT_L(0); PG8_MMA(1, 0, At, B0); PG8_BAR; PG8_SCHED;
            PG8_STAGE(PG8_SB(1, 1), b3 + hstep, voffB);
            PG8_WAIT_V(6); PG8_BAR; PG8_MMA(1, 1, At, B1); PG8_BAR;
            }
        }
        if constexpr (ALIGN_EPI) { if (wr == 0) PG8_BAR; }
        if constexpr (!Epi::AFTER_DRAIN) { E(acc, cur, wr, wc, fr, fq); S.done(cur); }
        if (!has_next) break;
#pragma unroll
        for (int a = 0; a < 2; ++a)
#pragma unroll
            for (int b = 0; b < 2; ++b)
#pragma unroll
                for (int m = 0; m < 4; ++m)
#pragma unroll
                    for (int n = 0; n < 2; ++n) acc[a][b][m][n] = (f32x4){0.f, 0.f, 0.f, 0.f};
        cur = nxt; cA = nA; cB = nB; ++ui;
        if constexpr (ALIGN_EPI) { if (wr == 1) PG8_BAR; }
    }
    PG8_WAIT_V(0);
    if constexpr (!ALIGN_EPI) { if (wr == 0) PG8_BAR; }
    PG8_BAR;
    if constexpr (Epi::AFTER_DRAIN) { E.fused(acc, cur, wr, wc, fr, fq, lds, wid, lane); S.done(cur); }
#undef PG8_SA
#undef PG8_SB
#undef PG8_STAGE
#undef PG8_LDA
#undef PG8_LDB
#undef PG8_MMA
#undef PG8_WAIT_V
#undef PG8_WAIT_L
#undef PG8_BAR
#undef PG8_SCHED
}
}

using pg8::bf16_t; using pg8::bf16x8; using pg8::f32x4; using pg8::u32x4;
typedef float f32x16 __attribute__((ext_vector_type(16)));
typedef float f32x8 __attribute__((ext_vector_type(8)));
typedef unsigned u32x2 __attribute__((ext_vector_type(2)));

constexpr int D = 1024, SEQ = 8192, NB = 2, NMETA = 16, LSEQ = SEQ + NMETA, MX = NB * SEQ, MROWS = MX + NB * NMETA;
constexpr int NEARLY = 96;
constexpr int DFF = 2816, NCH = 129, LP = NCH * 64, NREC = 16 * NCH;
constexpr float EPS = 1e-6f;
constexpr int REC_BYTES = 73728;
constexpr size_t WS_WIN = 0;
constexpr size_t WS_REC = 8912896;
constexpr size_t HN_BYTES = (size_t)MROWS * 1024 * 2;
constexpr size_t WS_R4 = WS_REC + (size_t)NREC * REC_BYTES;
constexpr size_t OBUF_BYTES = (size_t)16 * LP * 128 * 2;
constexpr size_t WS_W2 = WS_R4 + OBUF_BYTES;
constexpr size_t W_OUT = WS_W2, W_GU0 = WS_R4 + 50331648, W_QKV = W_GU0 + 11534336, W_O = W_QKV + 6291456, W_GU1 = W_O + 2097152, W_D1 = W_GU1 + 11534336, W_END = W_D1 + 5767168;
static_assert(W_OUT + 2097152 <= WS_R4 + 37337088 && W_END <= WS_R4 + 87668736, "weight copies vs late qkvpre rows");
constexpr size_t WS_MISC = WS_R4 + (size_t)MROWS * 3072 * 2;
constexpr size_t WS_HMETA = WS_MISC, WS_EXPGL = WS_MISC + 131072, WS_BAR = WS_EXPGL + 8448, WS_FLAGS = WS_BAR + 16384, W_D0 = WS_FLAGS + 8448, WS_END = W_D0 + 5767168;
static_assert(WS_END <= 268435456ull, "workspace");
constexpr int LDS_BYTES = 131072 + 16;

constexpr size_t WS_H16A = 8912896 + (size_t)33619968 + (size_t)92454912, H16_SPLIT = 12288;
__device__ __forceinline__ bf16_t* h16row(unsigned char* ws, int r) { return (bf16_t*)(ws + (r < (int)H16_SPLIT ? WS_H16A + (size_t)r * 2048 : (size_t)(r - (int)H16_SPLIT) * 2048)); }
__device__ __forceinline__ size_t vt_index(int bh, int d, int p) { return (((size_t)bh * (LP / 32) + (p >> 5)) * 64 + d) * 32 + (p & 31); }
__device__ __forceinline__ int rowof(int b, int p) { return p < NMETA ? MX + b * NMETA + p : b * SEQ + p - NMETA; }
typedef __bf16 bf16x2_t __attribute__((ext_vector_type(2)));
typedef float f32x2_t __attribute__((ext_vector_type(2)));
__device__ __forceinline__ unsigned pk2(float lo, float hi) { const f32x2_t v = {lo, hi}; const bf16x2_t b = __builtin_convertvector(v, bf16x2_t); return __builtin_bit_cast(unsigned, b); }
__device__ __forceinline__ bf16_t f2bf(float x) { return (bf16_t)(pk2(x, 0.f) & 0xffffu); }
__device__ __forceinline__ float bf2f(unsigned short v) { return __uint_as_float(((unsigned)v) << 16); }
__device__ __forceinline__ float bflo(unsigned w) { return __uint_as_float(w << 16); }
__device__ __forceinline__ float bfhi(unsigned w) { return __uint_as_float(w & 0xffff0000u); }
__device__ __forceinline__ float wave_sum(float v) {
#pragma unroll
    for (int o = 1; o < 64; o <<= 1) v += __shfl_xor(v, o);
    return v;
}
__device__ __forceinline__ float siluf(float x) { return x * __frcp_rn(1.0f + __expf(-x)); }
__device__ __forceinline__ f32x4 mfma16(bf16x8 a, bf16x8 b, f32x4 c) { return __builtin_amdgcn_mfma_f32_16x16x32_bf16(a, b, c, 0, 0, 0); }
__device__ __forceinline__ f32x16 mfma32(bf16x8 a, bf16x8 b, f32x16 c) { return __builtin_amdgcn_mfma_f32_32x32x16_bf16(a, b, c, 0, 0, 0); }
__device__ __forceinline__ bf16x8 as_bf16x8(u32x4 v) { union { u32x4 u; bf16x8 b; } x; x.u = v; return x.b; }
__device__ __forceinline__ bf16x8 pack8(f32x4 x, f32x4 y) { u32x4 v; v.x = pk2(x[0], x[1]); v.y = pk2(x[2], x[3]); v.z = pk2(y[0], y[1]); v.w = pk2(y[2], y[3]); return as_bf16x8(v); }
#define LDSWAIT() asm volatile("s_waitcnt lgkmcnt(0)" ::: "memory")

enum { EM_PROJ = 0, EM_QKV = 1, EM_SWIGLU = 2, EM_RES = 3 };
template <int mode> struct EpiUni {
    static constexpr bool PERM = true, AFTER_DRAIN = false;
    bf16_t* o0; bf16_t* o1; bf16_t* vt; const float* res; float* outf;
    __device__ __forceinline__ void operator()(const f32x4 (&acc)[2][2][4][2], const pg8::Unit& u, int wr, int wc, int fr, int fq) const {
        const int row0 = u.pm * 256 + wr * 64 + fr, ct = u.pn * 256 + wc * 32 + 8 * fq;
        if (mode == EM_SWIGLU) {
            const int col = u.pn * 128 + wc * 32 + 8 * fq;
#pragma unroll
            for (int ai = 0; ai < 2; ++ai)
#pragma unroll
                for (int m = 0; m < 4; ++m) {
                    const int row = row0 + ai * 128 + m * 16; float v[8];
#pragma unroll
                    for (int e = 0; e < 8; ++e) v[e] = siluf(acc[ai][0][m][e >> 2][e & 3]) * acc[ai][1][m][e >> 2][e & 3];
                    u32x4 w; w.x = pk2(v[0], v[1]); w.y = pk2(v[2], v[3]); w.z = pk2(v[4], v[5]); w.w = pk2(v[6], v[7]);
                    *(u32x4*)(o0 + (size_t)row * DFF + col) = w;
                    asm volatile("" ::: "memory");
                }
        } else if (mode == EM_RES) {
#pragma unroll
            for (int ai = 0; ai < 2; ++ai)
#pragma unroll
                for (int m = 0; m < 4; ++m) {
                    const int row = row0 + ai * 128 + m * 16;
                    bf16_t* hp = h16row((unsigned char*)outf, row) + ct;
#pragma unroll
                    for (int bj = 0; bj < 2; ++bj) {
                        f32x4 r0, r1;
                        if (res) { r0 = *(const f32x4*)(res + (size_t)row * D + ct + bj * 128); r1 = *(const f32x4*)(res + (size_t)row * D + ct + bj * 128 + 4); }
                        else { const u32x4 hv = *(const u32x4*)(hp + bj * 128); r0 = (f32x4){bflo(hv.x), bfhi(hv.x), bflo(hv.y), bfhi(hv.y)}; r1 = (f32x4){bflo(hv.z), bfhi(hv.z), bflo(hv.w), bfhi(hv.w)}; }
                        const f32x4 o0v = r0 + acc[ai][bj][m][0], o1v = r1 + acc[ai][bj][m][1];
                        u32x4 w; w.x = pk2(o0v.x, o0v.y); w.y = pk2(o0v.z, o0v.w); w.z = pk2(o1v.x, o1v.y); w.w = pk2(o1v.z, o1v.w);
                        *(u32x4*)(hp + bj * 128) = w;
                    }
                    asm volatile("" ::: "memory");
                }
        } else {
            const bool gatecols = (mode == EM_PROJ) && (u.pn >= 12);
            bf16_t* const p0 = o0; bf16_t* const p1 = o1;
            bf16_t* const base = gatecols ? p1 : p0;
            const int ldc = (mode == EM_PROJ) ? (gatecols ? 1024 : 3072) : 2048, cb = gatecols ? ct - 3072 : ct;
            const bool tr = (mode == EM_QKV) && (u.pn >= 8);
            if (!tr) {
#pragma unroll
                for (int ai = 0; ai < 2; ++ai)
#pragma unroll
                    for (int m = 0; m < 4; ++m) {
                        bf16_t* rp = base + (size_t)(row0 + ai * 128 + m * 16) * ldc + cb;
#pragma unroll
                        for (int bj = 0; bj < 2; ++bj) {
                            const f32x4 v0 = acc[ai][bj][m][0], v1 = acc[ai][bj][m][1];
                            u32x4 w; w.x = pk2(v0[0], v0[1]); w.y = pk2(v0[2], v0[3]); w.z = pk2(v1[0], v1[1]); w.w = pk2(v1[2], v1[3]);
                            *(u32x4*)(rp + bj * 128) = w;
                        }
                    }
            } else {
#pragma unroll
                for (int ai = 0; ai < 2; ++ai)
#pragma unroll
                    for (int m = 0; m < 4; ++m) {
                        const int row = row0 + ai * 128 + m * 16, b = row >> 13, p = (row & 8191) + NMETA;
#pragma unroll
                        for (int bj = 0; bj < 2; ++bj)
#pragma unroll
                            for (int e = 0; e < 8; ++e) {
                                const int cv = ct + bj * 128 - 2048 + e;
                                vt[vt_index(b * 16 + (cv >> 6), cv & 63, p)] = f2bf(acc[ai][bj][m][e >> 2][e & 3]);
                            }
                    }
            }
        }
    }
};

template <int NIT> __device__ __forceinline__ f32x4 tail_dot(const bf16_t* a, const bf16_t* b) {
    bf16x8 av[NIT], bv[NIT];
#pragma unroll
    for (int i = 0; i < NIT; ++i) { av[i] = *(const bf16x8*)(a + 32 * i); bv[i] = *(const bf16x8*)(b + 32 * i); }
    f32x4 acc = {0.f, 0.f, 0.f, 0.f};
#pragma unroll
    for (int i = 0; i < NIT; ++i) acc = mfma16(av[i], bv[i], acc);
    return acc;
}
struct TailP { const bf16_t* A; const bf16_t* Bt; int K; bf16_t* o0; bf16_t* o1; bf16_t* vt; float* ab; const float* res; float* outf; };
template <int MODE> __device__ __forceinline__ void tail_gemm(const TailP& T, unsigned char* lds, int tid) {
    const int lane = tid & 63, wid = __builtin_amdgcn_readfirstlane(tid >> 6), fr = lane & 15, fq = lane >> 4;
    const int nct = MODE == EM_PROJ ? 257 : MODE == EM_QKV ? 192 : MODE == EM_SWIGLU ? 176 : 64;
    const int ntile = 2 * nct + (MODE == EM_PROJ ? 1024 : 0);
    f32x4* red = (f32x4*)lds;
    const int ks = T.K >> 3;
    const int vblk = (MODE == EM_SWIGLU) ? (int)((blockIdx.x + gridDim.x / 2) % gridDim.x) : (int)blockIdx.x;
    for (int t = vblk; t < ntile; t += gridDim.x) {
        int rbase, ct;
        if (t < 2 * nct) { rbase = MX + (t & 1) * 16; ct = t >> 1; } else { rbase = (t - 2 * nct) * 16; ct = 256; }
        const bf16_t* ap = T.A + (size_t)(rbase + fr) * T.K + wid * ks + fq * 8;
        const int c0 = ct * 16;
        const int brow = (MODE == EM_SWIGLU) ? (c0 >> 7) * 256 + (c0 & 127) + fr : c0 + fr;
        const bf16_t* bp = T.Bt + (size_t)brow * T.K + wid * ks + fq * 8;
        if (T.K == 1024) red[wid * 64 + lane] = tail_dot<4>(ap, bp); else red[wid * 64 + lane] = tail_dot<11>(ap, bp);
        if (MODE == EM_SWIGLU) red[512 + wid * 64 + lane] = tail_dot<4>(ap, bp + (size_t)128 * T.K);
        __syncthreads();
        if (wid == 0) {
            f32x4 acc = red[lane];
#pragma unroll
            for (int w = 1; w < 8; ++w) acc += red[w * 64 + lane];
            const int col = c0 + fr;
            if (MODE == EM_SWIGLU) {
                f32x4 up = red[512 + lane];
#pragma unroll
                for (int w = 1; w < 8; ++w) up += red[512 + w * 64 + lane];
#pragma unroll
                for (int j = 0; j < 4; ++j) T.o0[(size_t)(rbase + fq * 4 + j) * DFF + col] = f2bf(siluf(acc[j]) * up[j]);
            } else {
#pragma unroll
                for (int j = 0; j < 4; ++j) {
                    const int row = rbase + fq * 4 + j;
                    if (MODE == EM_RES) { const int mr = row - MX; T.outf[mr * D + col] = T.res[(T.res == T.outf ? mr : (mr & 15)) * D + col] + acc[j]; }
                    else if (MODE == EM_PROJ) {
                        if (col < 3072) T.o0[(size_t)row * 3072 + col] = f2bf(acc[j]);
                        else if (col < 4096) T.o1[(size_t)row * 1024 + col - 3072] = f2bf(acc[j]);
                        else T.ab[(size_t)row * 16 + col - 4096] = acc[j];
                    } else {
                        if (col < 2048) T.o0[(size_t)row * 2048 + col] = f2bf(acc[j]);
                        else { const int cv = col - 2048, b = (row - MX) >> 4, p = (row - MX) & 15; T.vt[vt_index(b * 16 + (cv >> 6), cv & 63, p)] = f2bf(acc[j]); }
                    }
                }
            }
        }
        __syncthreads();
    }
}

__device__ __forceinline__ void transpose_item(const float* W, int K, int N, int nblk, const float* gain, bf16_t* WT, int mapmode, float* scr, int item, int lane) {
    const int kb = item / nblk, nb = item % nblk, k0 = 64 * kb, n0 = 32 * nb;
    const int nn = n0 + (lane & 31);
#pragma unroll 8
    for (int i = 0; i < 32; ++i) {
        const int kk = 2 * i + (lane >> 5);
        float v = 0.f;
        if (nn < N) v = W[(size_t)(k0 + kk) * N + nn] * (gain ? gain[k0 + kk] : 1.0f);
        scr[kk * 33 + (lane & 31)] = v;
    }
    LDSWAIT();
    int d0 = n0;
    if (mapmode == 1) d0 = n0 < DFF ? (n0 >> 7) * 256 + (n0 & 127) : ((n0 - DFF) >> 7) * 256 + 128 + ((n0 - DFF) & 127);
    const int c = lane & 7;
#pragma unroll
    for (int j = 0; j < 4; ++j) {
        const int n = (lane >> 3) + 8 * j; const float* s = scr + (8 * c) * 33 + n;
        u32x4 o; o.x = pk2(s[0 * 33], s[1 * 33]); o.y = pk2(s[2 * 33], s[3 * 33]); o.z = pk2(s[4 * 33], s[5 * 33]); o.w = pk2(s[6 * 33], s[7 * 33]);
        *(u32x4*)(WT + (size_t)(d0 + n) * K + k0 + 8 * c) = o;
    }
    LDSWAIT();
}

template <class SrcFn> __device__ __forceinline__ void rms_rows_bf16(SrcFn src, bf16_t* dst, int nrows, int gw, int NGW, int lane) {
    f32x4 v[4], nv[4];
    int r = gw;
    if (r < nrows) { const f32x4* s = (const f32x4*)src(r) + lane;
#pragma unroll
        for (int j = 0; j < 4; ++j) v[j] = s[64 * j]; }
    for (; r < nrows; r += NGW) {
        const int rn = r + NGW;
        if (rn < nrows) { const f32x4* s = (const f32x4*)src(rn) + lane;
#pragma unroll
            for (int j = 0; j < 4; ++j) nv[j] = s[64 * j]; }
        float ss = 0.f;
#pragma unroll
        for (int j = 0; j < 4; ++j) ss += (v[j].x * v[j].x + v[j].y * v[j].y) + (v[j].z * v[j].z + v[j].w * v[j].w);
        const float rr = rsqrtf(wave_sum(ss) * (1.0f / 1024.0f) + EPS);
        u32x2* o = (u32x2*)(dst + (size_t)r * D) + lane;
#pragma unroll
        for (int j = 0; j < 4; ++j) { u32x2 w; w.x = pk2(v[j].x * rr, v[j].y * rr); w.y = pk2(v[j].z * rr, v[j].w * rr); o[64 * j] = w; }
#pragma unroll
        for (int j = 0; j < 4; ++j) v[j] = nv[j];
    }
}
__device__ __forceinline__ void rms_row_bf16(const float* src, bf16_t* dst, int lane) {
    const f32x4* s = (const f32x4*)src + lane; f32x4 v[4]; float ss = 0.f;
#pragma unroll
    for (int j = 0; j < 4; ++j) { v[j] = s[64 * j]; ss += (v[j].x * v[j].x + v[j].y * v[j].y) + (v[j].z * v[j].z + v[j].w * v[j].w); }
    const float r = rsqrtf(wave_sum(ss) * (1.0f / 1024.0f) + EPS);
    u32x2* o = (u32x2*)dst + lane;
#pragma unroll
    for (int j = 0; j < 4; ++j) { u32x2 w; w.x = pk2(v[j].x * r, v[j].y * r); w.y = pk2(v[j].z * r, v[j].w * r); o[64 * j] = w; }
}
__device__ __forceinline__ void rms_rows_h16(unsigned char* ws, const float* hmeta, bf16_t* dst, int gw, int NGW, int lane) {
    u32x4 v[2], nv[2];
    int r = gw;
    if (r < MX) { const u32x4* s = (const u32x4*)h16row(ws, r) + lane; v[0] = s[0]; v[1] = s[64]; }
    for (; r < MX; r += NGW) {
        if (r + NGW < MX) { const u32x4* s = (const u32x4*)h16row(ws, r + NGW) + lane; nv[0] = s[0]; nv[1] = s[64]; }
        float f[16]; float ss = 0.f;
#pragma unroll
        for (int j = 0; j < 2; ++j) { f[8 * j] = bflo(v[j].x); f[8 * j + 1] = bfhi(v[j].x); f[8 * j + 2] = bflo(v[j].y); f[8 * j + 3] = bfhi(v[j].y);
                                      f[8 * j + 4] = bflo(v[j].z); f[8 * j + 5] = bfhi(v[j].z); f[8 * j + 6] = bflo(v[j].w); f[8 * j + 7] = bfhi(v[j].w); }
#pragma unroll
        for (int e = 0; e < 16; ++e) ss += f[e] * f[e];
        const float rr = rsqrtf(wave_sum(ss) * (1.0f / 1024.0f) + EPS);
        u32x4* o = (u32x4*)(dst + (size_t)r * D) + lane;
#pragma unroll
        for (int j = 0; j < 2; ++j) { u32x4 w; w.x = pk2(f[8 * j] * rr, f[8 * j + 1] * rr); w.y = pk2(f[8 * j + 2] * rr, f[8 * j + 3] * rr);
                                      w.z = pk2(f[8 * j + 4] * rr, f[8 * j + 5] * rr); w.w = pk2(f[8 * j + 6] * rr, f[8 * j + 7] * rr); o[64 * j] = w; }
        v[0] = nv[0]; v[1] = nv[1];
    }
    for (r = MX + gw; r < MROWS; r += NGW) rms_row_bf16(hmeta + (size_t)(r - MX) * D, dst + (size_t)r * D, lane);
}

__device__ __forceinline__ u32x4 ld_row8_raw(const bf16_t* base, int b, int p, int col) {
    u32x4 v = {0u, 0u, 0u, 0u};
    if (p >= 0) v = *(const u32x4*)(base + (size_t)rowof(b, p) * 3072 + col);
    return v;
}
__device__ __forceinline__ f32x8 cvt_row8(u32x4 v) {
    f32x8 r; r[0] = bflo(v.x); r[1] = bfhi(v.x); r[2] = bflo(v.y); r[3] = bfhi(v.y); r[4] = bflo(v.z); r[5] = bfhi(v.z); r[6] = bflo(v.w); r[7] = bfhi(v.w); return r;
}
__device__ __forceinline__ f32x8 ld_row8(const bf16_t* base, int b, int p, int col) {
    f32x8 r = {0.f, 0.f, 0.f, 0.f, 0.f, 0.f, 0.f, 0.f};
    if (p >= 0) {
        const u32x4 v = *(const u32x4*)(base + (size_t)rowof(b, p) * 3072 + col);
        r[0] = bflo(v.x); r[1] = bfhi(v.x); r[2] = bflo(v.y); r[3] = bfhi(v.y); r[4] = bflo(v.z); r[5] = bfhi(v.z); r[6] = bflo(v.w); r[7] = bfhi(v.w);
    }
    return r;
}
__device__ __forceinline__ int kperm(int k) { const int kk = k & 31; return (k & ~31) + ((kk >> 2) & 3) * 8 + ((kk >> 4) << 2) + (kk & 3); }
__device__ __forceinline__ int uperm(int m) { return (m & 3) * 8 + (m >> 2) * 4; }
__device__ __forceinline__ void gdn_prep(unsigned char* lds, const bf16_t* qkvpre, const float* ab, const float* conv_w, const float* a_log,
                                         const float* dt_bias, unsigned char* rec, float* expgl, int tid0, int it0, int itn, int itstep, bool late, unsigned* flags) {
    bf16_t* Qn = (bf16_t*)(lds);
    bf16_t* Kn = (bf16_t*)(lds + 17408);
    constexpr int XS = 144;
    float* Kf = (float*)(lds + 34816);
    float* Vf = (float*)(lds + 71680);
    float* Am = (float*)(lds + 108544);
    float* Gs = (float*)(lds + 124928);
    float* Td = (float*)(lds + 125696);
    float* Bs = Gs + 64; float* Es = Gs + 128;
    u32x4 raw[11]; float pf_a = 0.f, pf_b = 0.f;
#define PREP_PREFETCH(it_) do { if ((it_) < itn) { const int bh_ = late ? ((it_) & 15) : (it_) / NEARLY, n_ = late ? NEARLY + ((it_) >> 4) : (it_) % NEARLY, b_ = bh_ >> 3, h_ = bh_ & 7; \
        if (tid < 384) { const int cgi_ = tid % 48, ts_ = tid / 48; const int col_ = (cgi_ >> 4) * 1024 + h_ * 128 + (cgi_ & 15) * 8, p0_ = n_ * 64 - 48 + ts_ * 8; \
            _Pragma("unroll") for (int q = 0; q < 11; ++q) raw[q] = ld_row8_raw(qkvpre, b_, p0_ - 3 + q, col_); } \
        if (tid < 64) { const int p_ = n_ * 64 - 48 + tid; pf_a = 0.f; pf_b = 0.f; if (p_ >= 0) { const int row_ = rowof(b_, p_); pf_a = ab[(size_t)row_ * 16 + h_]; pf_b = ab[(size_t)row_ * 16 + 8 + h_]; } } } } while (0)
    { int tid = tid0; asm volatile("" : "+v"(tid)); PREP_PREFETCH(it0); }
    for (int it = it0; it < itn; it += itstep) {
        int tid = tid0; asm volatile("" : "+v"(tid));
        const int lane = tid & 63, wid = __builtin_amdgcn_readfirstlane(tid >> 6);
        const int bh = late ? (it & 15) : it / NEARLY, n = late ? NEARLY + (it >> 4) : it % NEARLY, b = bh >> 3, h = bh & 7;
        const int ridx = bh * NCH + n;
        unsigned char* R = rec + (size_t)ridx * REC_BYTES;
        if (wid == 0) {
            const int p = n * 64 - 48 + lane;
            float g = 0.f, be = 0.f;
            if (p >= 0) {
                const float a = pf_a, bb = pf_b;
                const float x = a + dt_bias[h];
                const float sp = fmaxf(x, 0.f) + __logf(1.0f + __expf(-fabsf(x)));
                g = -__expf(a_log[h]) * sp; be = 1.0f / (1.0f + __expf(-bb));
            }
            float G = g;
#pragma unroll
            for (int o = 1; o < 64; o <<= 1) { const float t = __shfl_up(G, o); if (lane >= o) G += t; }
            Gs[lane] = G; Bs[lane] = be; Es[lane] = __expf(G);
            if (lane == 63) expgl[ridx] = __expf(G);
        }
        __syncthreads();
#ifndef REP1
#define REP1 1
#endif
        if (tid < 384) {
            const int cgi = tid % 48, ts = tid / 48, sec = cgi >> 4, c0 = (cgi & 15) * 8;
            const int col = sec * 1024 + h * 128 + c0;
            f32x8 w0, w1, w2, w3;
            { const f32x4* wp = (const f32x4*)(conv_w + col);
              const f32x4 a0 = wp[0], a1 = wp[1], b0 = wp[768], b1 = wp[769], c0v = wp[1536], c1v = wp[1537], d0 = wp[2304], d1 = wp[2305];
              w0 = (f32x8){a0.x, a0.y, a0.z, a0.w, a1.x, a1.y, a1.z, a1.w}; w1 = (f32x8){b0.x, b0.y, b0.z, b0.w, b1.x, b1.y, b1.z, b1.w};
              w2 = (f32x8){c0v.x, c0v.y, c0v.z, c0v.w, c1v.x, c1v.y, c1v.z, c1v.w}; w3 = (f32x8){d0.x, d0.y, d0.z, d0.w, d1.x, d1.y, d1.z, d1.w}; }
            f32x8 x0 = cvt_row8(raw[0]), x1 = cvt_row8(raw[1]), x2 = cvt_row8(raw[2]);
#pragma unroll
            for (int tt = 0; tt < 8; ++tt) {
                const int i = ts * 8 + tt;
                const f32x8 x3 = cvt_row8(raw[3 + tt]);
                f32x8 y = w0 * x0 + w1 * x1 + w2 * x2 + w3 * x3;
                float ss = 0.f;
#pragma unroll
                for (int e = 0; e < 8; ++e) { y[e] = siluf(y[e]); ss += y[e] * y[e]; }
                ss += __shfl_xor(ss, 1); ss += __shfl_xor(ss, 2); ss += __shfl_xor(ss, 4); ss += __shfl_xor(ss, 8);
                if (sec == 0) {
                    const float r = rsqrtf(ss + EPS) * 0.08838834764831845f;
                    y = y * r;
                    u32x4 w; w.x = pk2(y[0], y[1]); w.y = pk2(y[2], y[3]); w.z = pk2(y[4], y[5]); w.w = pk2(y[6], y[7]);
                    *(u32x4*)(Qn + i * 136 + c0) = w;
                    const float eg = Es[i]; y = y * eg;
                    w.x = pk2(y[0], y[1]); w.y = pk2(y[2], y[3]); w.z = pk2(y[4], y[5]); w.w = pk2(y[6], y[7]);
                    {   const int blk = c0 & ~31, m0 = (c0 & 31) >> 2; u32x2 wa, wb; wa.x = w.x; wa.y = w.y; wb.x = w.z; wb.y = w.w;
                        *(u32x2*)(R + 16384 + (i * 128 + blk + uperm(m0)) * 2) = wa; *(u32x2*)(R + 16384 + (i * 128 + blk + uperm(m0 + 1)) * 2) = wb; }
                } else if (sec == 1) {
                    const float r = rsqrtf(ss + EPS);
                    y = y * r;
                    u32x4 w; w.x = pk2(y[0], y[1]); w.y = pk2(y[2], y[3]); w.z = pk2(y[4], y[5]); w.w = pk2(y[6], y[7]);
                    *(u32x4*)(Kn + i * 136 + c0) = w;
                    *(f32x4*)(Kf + i * XS + c0) = (f32x4){y[0], y[1], y[2], y[3]}; *(f32x4*)(Kf + i * XS + c0 + 4) = (f32x4){y[4], y[5], y[6], y[7]};
                } else {
                    *(f32x4*)(Vf + i * XS + c0) = (f32x4){y[0], y[1], y[2], y[3]}; *(f32x4*)(Vf + i * XS + c0 + 4) = (f32x4){y[4], y[5], y[6], y[7]};
                }
                x0 = x1; x1 = x2; x2 = x3;
            }
        }
        PREP_PREFETCH(it + itstep);
        __syncthreads();
#ifndef REP2
#define REP2 1
#endif
        for (int rep2 = 0; rep2 < REP2; ++rep2)
        {
            const int which = wid >> 2, ti = wid & 3, fr = lane & 15, fq = lane >> 4;
            const bf16_t* As = which ? Qn : Kn;
            bf16x8 af[4];
#pragma unroll
            for (int ks = 0; ks < 4; ++ks) af[ks] = *(const bf16x8*)(As + (ti * 16 + fr) * 136 + ks * 32 + fq * 8);
            bf16_t* attn = (bf16_t*)(R + 32768);
#pragma unroll
            for (int tj = 0; tj < 4; ++tj) {
                f32x4 acc = {0.f, 0.f, 0.f, 0.f};
#pragma unroll
                for (int ks = 0; ks < 4; ++ks) acc = mfma16(af[ks], *(const bf16x8*)(Kn + (tj * 16 + fr) * 136 + ks * 32 + fq * 8), acc);
                const int j = tj * 16 + fr; const float Gj = Gs[j];
#pragma unroll
                for (int r = 0; r < 4; ++r) {
                    const int i = ti * 16 + fq * 4 + r;
                    const float dec = (j <= i) ? __expf(Gs[i] - Gj) : 0.f;
                    if (which == 0) Am[j * 64 + i] = (j < i) ? Bs[i] * dec * acc[r] : 0.f;
                    else attn[i * 64 + kperm(j)] = f2bf(dec * acc[r]);
                }
            }
            if (which == 0 && lane < 16) {
                LDSWAIT();
                float t[16];
#pragma unroll
                for (int i = 0; i < 16; ++i) t[i] = (i == lane) ? 1.0f : 0.0f;
#pragma unroll
                for (int j = 0; j < 15; ++j) {
                    const float* ap = Am + (ti * 16 + j) * 64 + ti * 16;
#pragma unroll
                    for (int i = j + 1; i < 16; ++i) t[i] -= ap[i] * t[j];
                }
#pragma unroll
                for (int i = 0; i < 16; i += 4) *(f32x4*)(Td + ti * 256 + lane * 16 + i) = (f32x4){t[i], t[i + 1], t[i + 2], t[i + 3]};
            }
        }
        {
            const float Gl = Gs[63];
#pragma unroll
            for (int k = 0; k < 2; ++k) {
                const int q = tid + 512 * k, d = q & 127, ig = q >> 7;
                float v[8];
#pragma unroll
                for (int e = 0; e < 8; ++e) { const int i = ig * 8 + e; v[e] = Kf[i * XS + d] * __expf(Gl - Gs[i]); }
                u32x4 w; w.x = pk2(v[0], v[1]); w.y = pk2(v[2], v[3]); w.z = pk2(v[4], v[5]); w.w = pk2(v[6], v[7]);
                {   const int blk = (ig >> 2) * 32, m0 = (ig & 3) * 2; u32x2 wa, wb; wa.x = w.x; wa.y = w.y; wb.x = w.z; wb.y = w.w;
                    *(u32x2*)(R + 40960 + (d * 64 + blk + uperm(m0)) * 2) = wa; *(u32x2*)(R + 40960 + (d * 64 + blk + uperm(m0 + 1)) * 2) = wb; }
            }
        }
        __syncthreads();
        {
            int tl = tid0; asm volatile("" : "+v"(tl));
            const bool isU = wid < 4; float* X = isU ? Vf : Kf;
            const int c = tl & 15, g = (tl & 63) >> 4, colbase = (wid & 3) * 32;
#pragma unroll
            for (int kb = 0; kb < 4; ++kb) {
                f32x4 acc[2];
#pragma unroll
                for (int nt = 0; nt < 2; ++nt)
#pragma unroll
                    for (int r = 0; r < 4; ++r) { const int i = kb * 16 + 4 * g + r; acc[nt][r] = Bs[i] * (isU ? 1.0f : Es[i]) * X[i * XS + colbase + nt * 16 + c]; }
#pragma unroll
                for (int m = 0; m < kb; ++m)
#pragma unroll
                    for (int sx = 0; sx < 4; ++sx) {
                        const int kr = m * 16 + 4 * sx + g;
                        const float a = -Am[kr * 64 + kb * 16 + c];
#pragma unroll
                        for (int nt = 0; nt < 2; ++nt) acc[nt] = __builtin_amdgcn_mfma_f32_16x16x4f32(a, X[kr * XS + colbase + nt * 16 + c], acc[nt], 0, 0, 0);
                    }
#pragma unroll
                for (int nt = 0; nt < 2; ++nt)
#pragma unroll
                    for (int r = 0; r < 4; ++r) X[(kb * 16 + 4 * g + r) * XS + colbase + nt * 16 + c] = acc[nt][r];
                LDSWAIT();
                f32x4 xk[2];
                xk[0] = (f32x4){0.f, 0.f, 0.f, 0.f}; xk[1] = xk[0];
#pragma unroll
                for (int sx = 0; sx < 4; ++sx) {
                    const float a = Td[kb * 256 + (4 * sx + g) * 16 + c];
#pragma unroll
                    for (int nt = 0; nt < 2; ++nt) xk[nt] = __builtin_amdgcn_mfma_f32_16x16x4f32(a, X[(kb * 16 + 4 * sx + g) * XS + colbase + nt * 16 + c], xk[nt], 0, 0, 0);
                }
                LDSWAIT();
                if (kb < 3) {
#pragma unroll
                    for (int nt = 0; nt < 2; ++nt)
#pragma unroll
                        for (int r = 0; r < 4; ++r) X[(kb * 16 + 4 * g + r) * XS + colbase + nt * 16 + c] = xk[nt][r];
                    LDSWAIT();
                }
#pragma unroll
                for (int nt = 0; nt < 2; ++nt) {
                    const int col = colbase + nt * 16 + c;
                    if (isU) {
                        u32x2 w; w.x = pk2(xk[nt][0], xk[nt][1]); w.y = pk2(xk[nt][2], xk[nt][3]);
                        *(u32x2*)((bf16_t*)(R + 57344) + (((col >> 4) * 4 + kb) * 64 + lane) * 4) = w;
                    } else {
                        bf16_t* wn = (bf16_t*)R;
#pragma unroll
                        for (int r = 0; r < 4; ++r) wn[(kb * 16 + 4 * g + r) * 128 + kperm(col)] = f2bf(-xk[nt][r]);
                    }
                }
            }
        }
        if (late) asm volatile("s_waitcnt vmcnt(0)" ::: "memory");
        __syncthreads();
        if (late && tid == 0) {
            __builtin_amdgcn_fence(__ATOMIC_RELEASE, "agent"); asm volatile("s_waitcnt vmcnt(0)" ::: "memory");
            __hip_atomic_store(flags + ridx, 1u, __ATOMIC_RELAXED, __HIP_MEMORY_SCOPE_AGENT);
        }
    }
}

constexpr int SBUF = 62464;
__device__ __forceinline__ bf16x8 ldfrag(const unsigned char* base, int stride, int row, int kel, int g) {
    return *(const bf16x8*)(base + row * stride + (kel + 8 * g) * 2);
}
#define SC_LOAD(set, chunk) do { const unsigned char* _s = recb + (size_t)(chunk) * REC_BYTES; unsigned _vo = (unsigned)t2 * 16u; asm volatile("" : "+v"(_vo)); _Pragma("unroll") for (int _k = 0; _k < 14; ++_k) set[_k] = *(const u32x4*)(_s + _k * 4096 + _vo); } while (0)
#define SC_STORE(set, bufp) do { _Pragma("unroll") for (int _k = 0; _k < 14; ++_k) { const int _q = t2 + 256 * _k; int _o; \
        if (_k < 4) _o = (_q >> 4) * 272 + (_q & 15) * 16; else if (_k < 8) _o = 17408 + ((_q - 1024) >> 4) * 272 + (_q & 15) * 16; \
        else if (_k < 10) _o = 34816 + ((_q - 2048) >> 3) * 144 + (_q & 7) * 16; else _o = 44032 + ((_q - 2560) >> 3) * 144 + (_q & 7) * 16; \
        *(u32x4*)((bufp) + _o) = set[_k]; } } while (0)
__device__ __forceinline__ void gdn_scan(unsigned char* lds, const unsigned char* rec, const float* expgl, bf16_t* obuf, int tid, unsigned* flags) {
    const int bh = (blockIdx.x & 7) + 8 * (blockIdx.x >> 5), quarter = (blockIdx.x >> 3) & 3;
    const int lane = tid & 63, wid = tid >> 6;
    const unsigned char* recb = rec + (size_t)bh * NCH * REC_BYTES;
    if (wid >= 4) {
        const int t2 = tid - 256;
        u32x4 ra[14], rb[14];
        SC_LOAD(rb, 0); SC_STORE(rb, lds);
        SC_LOAD(ra, 1); SC_LOAD(rb, 2);
        __syncthreads();
        for (int n = 0; n < NCH; ++n) {
            unsigned char* nb = lds + ((n + 1) & 1) * SBUF;
            if (n & 1) { if (n + 1 < NCH) SC_STORE(rb, nb); if (n + 3 < NCH) SC_LOAD(rb, n + 3); }
            else       { if (n + 1 < NCH) SC_STORE(ra, nb); if (n + 3 < NCH) SC_LOAD(ra, n + 3); }
            if (wid == 4 && (n == NEARLY - 4 || n == NEARLY + 12)) {
                const int c = n + 4 + lane, cend = (n == NEARLY - 4) ? NEARLY + 16 : NCH;
                unsigned spins = 0;
                for (;;) {
                    const unsigned v = (c < cend) ? __hip_atomic_load(flags + bh * NCH + c, __ATOMIC_RELAXED, __HIP_MEMORY_SCOPE_AGENT) : 1u;
                    if (__all(v != 0u) || ++spins > (1u << 22)) break;
                    __builtin_amdgcn_s_sleep(8);
                }
                __builtin_amdgcn_fence(__ATOMIC_ACQUIRE, "agent");
                asm volatile("s_waitcnt vmcnt(0)" ::: "memory");
            }
            __syncthreads();
        }
    } else if (wid >= 2) {
        __syncthreads();
        for (int n = 0; n < NCH; ++n) __syncthreads();
    } else {
        const int fr = lane & 15, g = lane >> 4, slice = quarter * 2 + wid;
        f32x4 S[8]; bf16x8 Sb[4];
#pragma unroll
        for (int i = 0; i < 8; ++i) S[i] = (f32x4){0.f, 0.f, 0.f, 0.f};
#pragma unroll
        for (int i = 0; i < 4; ++i) Sb[i] = (bf16x8){0, 0, 0, 0, 0, 0, 0, 0};
        const float* ep = expgl + bh * NCH;
        float an = __hip_atomic_load(ep, __ATOMIC_RELAXED, __HIP_MEMORY_SCOPE_AGENT);
        u32x2 ubn[4];
        {   const u32x2* up = (const u32x2*)(recb + 57344) + (slice * 4) * 64 + lane;
#pragma unroll
            for (int rt = 0; rt < 4; ++rt) ubn[rt] = up[rt * 64]; }
        unsigned char* obb = (unsigned char*)(obuf + (size_t)bh * LP * 128);
        const unsigned ooff0 = (unsigned)((4 * g) * 128 + slice * 16 + fr) * 2u;
        __syncthreads();
        for (int n = 0; n < NCH; ++n) {
            const unsigned char* buf = lds + (n & 1) * SBUF;
            f32x4 ua[4], oa[4];
#pragma unroll
            for (int rt = 0; rt < 4; ++rt) { ua[rt] = (f32x4){bflo(ubn[rt].x), bfhi(ubn[rt].x), bflo(ubn[rt].y), bfhi(ubn[rt].y)}; oa[rt] = (f32x4){0.f, 0.f, 0.f, 0.f}; }
            const float a = an;
            if (n + 1 < NCH) { an = __hip_atomic_load(ep + n + 1, __ATOMIC_RELAXED, __HIP_MEMORY_SCOPE_AGENT);
                const u32x2* up = (const u32x2*)(recb + (size_t)(n + 1) * REC_BYTES + 57344) + (slice * 4) * 64 + lane;
#pragma unroll
                for (int rt = 0; rt < 4; ++rt) ubn[rt] = up[rt * 64]; }
#define SC_LDA(dst, rt_) do { _Pragma("unroll") for (int ks = 0; ks < 4; ++ks) { dst[ks] = ldfrag(buf, 272, (rt_) * 16 + fr, ks * 32, g); dst[4 + ks] = ldfrag(buf + 17408, 272, (rt_) * 16 + fr, ks * 32, g); } } while (0)
#define SC_MMA_A(src, rt_) do { _Pragma("unroll") for (int ks = 0; ks < 4; ++ks) { ua[rt_] = mfma16(src[ks], Sb[ks], ua[rt_]); oa[rt_] = mfma16(src[4 + ks], Sb[ks], oa[rt_]); } } while (0)
#define SC_SB() __builtin_amdgcn_sched_barrier(0)
            bf16x8 fA[8], fB[8];
            SC_LDA(fA, 0); SC_SB();
            SC_LDA(fB, 1); SC_SB(); SC_MMA_A(fA, 0); SC_SB();
            SC_LDA(fA, 2); SC_SB(); SC_MMA_A(fB, 1); SC_SB();
            SC_LDA(fB, 3); SC_SB(); SC_MMA_A(fA, 2); SC_SB();
#pragma unroll
            for (int rt = 0; rt < 4; ++rt) { fA[2 * rt] = ldfrag(buf + 34816, 144, rt * 16 + fr, 0, g); fA[2 * rt + 1] = ldfrag(buf + 34816, 144, rt * 16 + fr, 32, g); }
            SC_SB(); SC_MMA_A(fB, 3); SC_SB();
            bf16x8 ub2[2];
            ub2[0] = pack8(ua[0], ua[1]); ub2[1] = pack8(ua[2], ua[3]);
#pragma unroll
            for (int rt = 0; rt < 4; ++rt) { fB[2 * rt] = ldfrag(buf + 44032, 144, rt * 16 + fr, 0, g); fB[2 * rt + 1] = ldfrag(buf + 44032, 144, rt * 16 + fr, 32, g); }
            SC_SB();
#pragma unroll
            for (int rt = 0; rt < 4; ++rt) { oa[rt] = mfma16(fA[2 * rt], ub2[0], oa[rt]); oa[rt] = mfma16(fA[2 * rt + 1], ub2[1], oa[rt]); }
            SC_SB();
#pragma unroll
            for (int rt = 0; rt < 4; ++rt) { fA[2 * rt] = ldfrag(buf + 44032, 144, (4 + rt) * 16 + fr, 0, g); fA[2 * rt + 1] = ldfrag(buf + 44032, 144, (4 + rt) * 16 + fr, 32, g); }
            SC_SB();
#pragma unroll
            for (int rt = 0; rt < 4; ++rt) { f32x4 c = S[rt] * a; c = mfma16(fB[2 * rt], ub2[0], c); c = mfma16(fB[2 * rt + 1], ub2[1], c); S[rt] = c; }
            SC_SB();
#pragma unroll
            for (int rt = 0; rt < 4; ++rt) { f32x4 c = S[4 + rt] * a; c = mfma16(fA[2 * rt], ub2[0], c); c = mfma16(fA[2 * rt + 1], ub2[1], c); S[4 + rt] = c; }
#pragma unroll
            for (int ks = 0; ks < 4; ++ks) Sb[ks] = pack8(S[2 * ks], S[2 * ks + 1]);
            {   unsigned oo = ooff0 + (unsigned)n * 16384u; asm volatile("" : "+v"(oo));
#pragma unroll
                for (int rt = 0; rt < 4; ++rt)
#pragma unroll
                    for (int j = 0; j < 4; ++j) *(bf16_t*)(obb + (oo + (unsigned)(rt * 4096 + j * 256))) = f2bf(oa[rt][j]); }
            __syncthreads();
        }
    }
}

__device__ __forceinline__ void og_phase(const bf16_t* obuf, const bf16_t* gate, const float* onorm_g, bf16_t* og, int gw, int NGW, int lane) {
    const int hl = lane >> 4, dl = (lane & 15) * 8;
    float gn[8];
    { const f32x4 a = *(const f32x4*)(onorm_g + dl), b = *(const f32x4*)(onorm_g + dl + 4); gn[0] = a.x; gn[1] = a.y; gn[2] = a.z; gn[3] = a.w; gn[4] = b.x; gn[5] = b.y; gn[6] = b.z; gn[7] = b.w; }
    for (int r = gw; r < MROWS; r += NGW) {
        int b, p; if (r < MX) { b = r >> 13; p = (r & 8191) + NMETA; } else { b = (r - MX) >> 4; p = (r - MX) & 15; }
        const int pos = p + 48;
        u32x4 ov[2], gv[2];
#pragma unroll
        for (int q = 0; q < 2; ++q) {
            ov[q] = *(const u32x4*)(obuf + ((size_t)(b * 8 + 4 * q + hl) * LP + pos) * 128 + dl);
            gv[q] = *(const u32x4*)(gate + (size_t)r * 1024 + (4 * q + hl) * 128 + dl);
        }
#pragma unroll
        for (int q = 0; q < 2; ++q) {
            float o[8], gt[8];
            o[0] = bflo(ov[q].x); o[1] = bfhi(ov[q].x); o[2] = bflo(ov[q].y); o[3] = bfhi(ov[q].y); o[4] = bflo(ov[q].z); o[5] = bfhi(ov[q].z); o[6] = bflo(ov[q].w); o[7] = bfhi(ov[q].w);
            gt[0] = bflo(gv[q].x); gt[1] = bfhi(gv[q].x); gt[2] = bflo(gv[q].y); gt[3] = bfhi(gv[q].y); gt[4] = bflo(gv[q].z); gt[5] = bfhi(gv[q].z); gt[6] = bflo(gv[q].w); gt[7] = bfhi(gv[q].w);
            float ss = 0.f;
#pragma unroll
            for (int e = 0; e < 8; ++e) ss += o[e] * o[e];
            ss += __shfl_xor(ss, 1); ss += __shfl_xor(ss, 2); ss += __shfl_xor(ss, 4); ss += __shfl_xor(ss, 8);
            const float rinv = rsqrtf(ss * (1.0f / 128.0f) + EPS);
            float v[8];
#pragma unroll
            for (int e = 0; e < 8; ++e) v[e] = o[e] * rinv * gn[e] * siluf(gt[e]);
            u32x4 w; w.x = pk2(v[0], v[1]); w.y = pk2(v[2], v[3]); w.z = pk2(v[4], v[5]); w.w = pk2(v[6], v[7]);
            *(u32x4*)(og + (size_t)r * 1024 + (4 * q + hl) * 128 + dl) = w;
        }
    }
}

__device__ __forceinline__ void attn_phase(const bf16_t* qk, const bf16_t* vt, bf16_t* og, int gw, int NGW, int lane) {
    constexpr int NQB = (LSEQ + 31) / 32;
    const int ql = lane & 31, hh = lane >> 5;
    for (int it = gw; it < NB * 16 * NQB; it += NGW) {
        const int qb = it < NB * 16 * (NQB - 1) ? 1 + it % (NQB - 1) : 0, bh = it < NB * 16 * (NQB - 1) ? it / (NQB - 1) : it - NB * 16 * (NQB - 1), b = bh >> 4, h = bh & 15;
        const int qpos = qb * 32 + ql;
        bf16x8 qf[4];
        {   const bf16_t* qp = qk + (size_t)rowof(b, min(qpos, LSEQ - 1)) * 2048 + h * 64 + 8 * hh;
#pragma unroll
            for (int ks = 0; ks < 4; ++ks) qf[ks] = *(const bf16x8*)(qp + 16 * ks); }
        f32x16 o0, o1;
#pragma unroll
        for (int e = 0; e < 16; ++e) { o0[e] = 0.f; o1[e] = 0.f; }
        float R = 0.f;
        const bf16_t* vbase = vt + (size_t)bh * 64 * LP;
        for (int kb = qb; kb >= 0; --kb) {
            const bf16_t* kp = qk + (size_t)rowof(b, min(kb * 32 + ql, LSEQ - 1)) * 2048 + 1024 + h * 64 + 8 * hh;
            f32x16 z;
#pragma unroll
            for (int e = 0; e < 16; ++e) z[e] = 0.f;
#pragma unroll
            for (int ks = 0; ks < 4; ++ks) z = mfma32(*(const bf16x8*)(kp + 16 * ks), qf[ks], z);
            bf16x8 vb[2][2];
#pragma unroll
            for (int s = 0; s < 2; ++s)
#pragma unroll
                for (int dt = 0; dt < 2; ++dt) {
                    const bf16_t* vp = vbase + ((size_t)kb * 64 + ql + 32 * dt) * 32 + 16 * s + 4 * hh;
                    const u32x2 lo = *(const u32x2*)vp, hi = *(const u32x2*)(vp + 8);
                    u32x4 v; v.x = lo.x; v.y = lo.y; v.z = hi.x; v.w = hi.y; vb[s][dt] = as_bf16x8(v);
                }
            float lb[16], lk[16];
            if (kb == qb) {
#pragma unroll
                for (int e = 0; e < 16; ++e) {
                    const int key = kb * 32 + (e & 3) + 8 * (e >> 2) + 4 * hh;
                    const float zz = z[e] * 0.18033688011112042f;
                    const float sp = __builtin_amdgcn_logf(1.0f + __builtin_amdgcn_exp2f(-fabsf(zz)));
                    const bool vis = key < qpos;
                    const float l = fminf(zz, 0.f) - sp;
                    lb[e] = vis ? l : -1e30f;
                    lk[e] = vis ? l - zz : 0.f;
                }
            } else {
#pragma unroll
                for (int e = 0; e < 16; ++e) {
                    const float zz = z[e] * 0.18033688011112042f;
                    const float sp = __builtin_amdgcn_logf(1.0f + __builtin_amdgcn_exp2f(-fabsf(zz)));
                    lb[e] = fminf(zz, 0.f) - sp;
                    lk[e] = lb[e] - zz;
                }
            }
            float gs[4], pg[4];
#pragma unroll
            for (int m = 0; m < 4; ++m) gs[m] = (lk[4 * m] + lk[4 * m + 1]) + (lk[4 * m + 2] + lk[4 * m + 3]);
#pragma unroll
            for (int m = 0; m < 4; ++m) pg[m] = __shfl_xor(gs[m], 32);
            float w[16];
            float later = R;
#pragma unroll
            for (int m = 3; m >= 0; --m) {
                const float lat = later + (hh == 0 ? pg[m] : 0.f);
                const float s3 = lat, s2 = s3 + lk[4 * m + 3], s1 = s2 + lk[4 * m + 2], s0 = s1 + lk[4 * m + 1];
                w[4 * m + 3] = __builtin_amdgcn_exp2f(lb[4 * m + 3] + s3); w[4 * m + 2] = __builtin_amdgcn_exp2f(lb[4 * m + 2] + s2);
                w[4 * m + 1] = __builtin_amdgcn_exp2f(lb[4 * m + 1] + s1); w[4 * m] = __builtin_amdgcn_exp2f(lb[4 * m] + s0);
                later += gs[m] + pg[m];
            }
            R = later;
            u32x4 p0, p1;
            p0.x = pk2(w[0], w[1]); p0.y = pk2(w[2], w[3]); p0.z = pk2(w[4], w[5]); p0.w = pk2(w[6], w[7]);
            p1.x = pk2(w[8], w[9]); p1.y = pk2(w[10], w[11]); p1.z = pk2(w[12], w[13]); p1.w = pk2(w[14], w[15]);
            const bf16x8 pa0 = as_bf16x8(p0), pa1 = as_bf16x8(p1);
            o0 = mfma32(pa0, vb[0][0], o0); o0 = mfma32(pa1, vb[1][0], o0);
            o1 = mfma32(pa0, vb[0][1], o1); o1 = mfma32(pa1, vb[1][1], o1);
            if (__all(R < -160.0f)) break;
        }
#pragma unroll
        for (int e = 0; e < 16; ++e) {
            const int qp2 = qb * 32 + (e & 3) + 8 * (e >> 2) + 4 * hh;
            if (qp2 < LSEQ) { bf16_t* op = og + (size_t)rowof(b, qp2) * 1024 + h * 64 + ql; op[0] = f2bf(o0[e]); op[32] = f2bf(o1[e]); }
        }
    }
}

#define LAS __attribute__((address_space(3)))
#define XB_TMO      128
#define XB_XCNT(j)  (256  + 64 * (j))
#define XB_XSUB(j)  (1280 + 64 * (j))
#define XB_XGEN(j)  (2304 + 64 * (j))
#define XB_TOP      3328
#define XB_TOPGEN   3392
#define XCD_BAR_WORDS 3456
#define XB_SPIN_CAP (1u << 18)

__device__ __forceinline__ unsigned xb_ld(unsigned* p)              { return __hip_atomic_load(p, __ATOMIC_RELAXED, __HIP_MEMORY_SCOPE_AGENT); }
__device__ __forceinline__ unsigned xb_add(unsigned* p, unsigned v) { return __hip_atomic_fetch_add(p, v, __ATOMIC_RELAXED, __HIP_MEMORY_SCOPE_AGENT); }
__device__ __forceinline__ unsigned xb_xcc_id() { return (unsigned)__builtin_amdgcn_s_getreg((3 << 11) | 20) & 0xFu; }
#define XB_SPIN(cond, bar) do { unsigned _sp = 0; while (cond) { __builtin_amdgcn_s_sleep(1); \
    if ((++_sp & 255u) == 0u) { if (xb_ld(&(bar)[XB_TMO])) break; if (_sp > XB_SPIN_CAP) { atomicAdd(&(bar)[XB_TMO], 1u); break; } } } } while (0)

struct XcdBarrier {
    unsigned* bar; unsigned x;
    volatile LAS unsigned* st;
};

__device__ __forceinline__ XcdBarrier xcd_barrier_post(unsigned* bar, volatile LAS unsigned* st) {
    XcdBarrier b; b.bar = bar; b.x = xb_xcc_id(); b.st = st;
    if (threadIdx.x == 0) (void)xb_add(&bar[XB_XCNT(b.x)], 1u);
    return b;
}
__device__ __forceinline__ void xcd_barrier_complete(unsigned* bar, unsigned x, unsigned& nloc, unsigned& nx) {
    const unsigned G = gridDim.x * gridDim.y * gridDim.z;
    unsigned sum, cnt, mine, sp = 0u;
    for (;;) {
        sum = 0u; cnt = 0u; mine = 0u;
#pragma unroll
        for (unsigned j = 0; j < 16; ++j) { const unsigned c = xb_ld(&bar[XB_XCNT(j)]); sum += c; cnt += (c > 0u) ? 1u : 0u; mine = (j == x) ? c : mine; }
        if (sum == G) break;
        __builtin_amdgcn_s_sleep(1);
        if ((++sp & 255u) == 0u) { if (xb_ld(&bar[XB_TMO])) break; if (sp > XB_SPIN_CAP) { atomicAdd(&bar[XB_TMO], 1u); break; } }
    }
    nloc = mine > 0u ? mine : 1u; nx = cnt > 0u ? cnt : 1u;
}

__device__ __forceinline__ void xcd_barrier(const XcdBarrier& b) {
    asm volatile("s_waitcnt vmcnt(0)" ::: "memory");
    __syncthreads();
    if (threadIdx.x == 0) {
        unsigned* bar = b.bar;
        __builtin_amdgcn_s_waitcnt(0);
        unsigned nloc = b.st[0], nx = b.st[1];
        if (nloc == 0u) { xcd_barrier_complete(bar, b.x, nloc, nx); b.st[0] = nloc; b.st[1] = nx; }
        const unsigned old = xb_add(&bar[XB_XSUB(b.x)], 1u);
        const unsigned gen = old / nloc;
        if (old + 1u == (gen + 1u) * nloc) {
            __builtin_amdgcn_fence(__ATOMIC_RELEASE, "agent");
            asm volatile("s_waitcnt vmcnt(0)" ::: "memory");
            const unsigned og = xb_add(&bar[XB_TOP], 1u);
            const unsigned tg = og / nx;
            if (og + 1u == (tg + 1u) * nx) xb_add(&bar[XB_TOPGEN], 1u);
            else XB_SPIN(xb_ld(&bar[XB_TOPGEN]) == tg, bar);
            __builtin_amdgcn_fence(__ATOMIC_ACQUIRE, "agent");
            xb_add(&bar[XB_XGEN(b.x)], 1u);
            asm volatile("s_waitcnt vmcnt(0)" ::: "memory");
        } else {
            XB_SPIN(xb_ld(&bar[XB_XGEN(b.x)]) == gen, bar);
            __builtin_amdgcn_fence(__ATOMIC_ACQUIRE, "agent");
            asm volatile("s_waitcnt vmcnt(0)" ::: "memory");
        }
    }
    __syncthreads();
}


struct Params { const float* in[18]; float* out; unsigned char* ws; };
#define BAR_ALL() do { asm volatile("s_waitcnt vmcnt(0) lgkmcnt(0)" ::: "memory"); __syncthreads(); } while (0)
#define PH_BEGIN() \
    int tid = threadIdx.x; asm volatile("" : "+v"(tid)); \
    const int lane = tid & 63, wid = __builtin_amdgcn_readfirstlane(tid >> 6), gw = blockIdx.x * 8 + wid; (void)lane; (void)gw; \
    size_t zoff = 0; asm volatile("" : "+s"(zoff)); \
    unsigned char* ws = P.ws + zoff; float* dout = (float*)((unsigned char*)P.out + zoff); \
    bf16_t* WIN = (bf16_t*)(ws + WS_WIN); unsigned char* REC = ws + WS_REC; bf16_t* HN = (bf16_t*)(ws + WS_REC); bf16_t* ACT = (bf16_t*)(ws + WS_REC + HN_BYTES); \
    bf16_t* QKVPRE = (bf16_t*)(ws + WS_R4); bf16_t* GATE = (bf16_t*)dout; float* AB = (float*)((unsigned char*)dout + HN_BYTES); \
    float* HMETA = (float*)(ws + WS_HMETA); float* EXPGL = (float*)(ws + WS_EXPGL); float* scr = (float*)(lds + wid * 8448); \
    (void)WIN; (void)REC; (void)HN; (void)ACT; (void)QKVPRE; (void)GATE; (void)AB; (void)HMETA; (void)EXPGL; (void)scr;
#define SEAM() do { XcdBarrier xb; xb.bar = (unsigned*)(P.ws + WS_BAR); xb.x = xb_xcc_id(); xb.st = (volatile LAS unsigned*)(lds + 131072); xcd_barrier(xb); } while (0)

template <int MODE> __device__ __forceinline__ void gemm_full(unsigned char* lds, int G, const bf16_t* A, const bf16_t* Bt, int N, int K, bf16_t* o0, bf16_t* o1, bf16_t* vt,
                                                              const float* res, float* outf, float* tab, const float* tres, float* hmeta, int tid) {
    const pg8::Gemm g{A, Bt, MX, N, K};
    const EpiUni<MODE> E{o0, o1, vt, res, outf};
    pg8::StaticOrder S; S.init(MX, N, G, (int)blockIdx.x);
#ifndef GEMM_ALIGN
#define GEMM_ALIGN true
#endif
#ifndef GEMM_SP2
#define GEMM_SP2 true
#endif
    pg8::gemm_phase<EpiUni<MODE>, pg8::StaticOrder, GEMM_ALIGN, GEMM_SP2>((PG8_LAS unsigned char*)lds, g, S, E);
    const TailP T{A, Bt, K, o0, o1, vt, tab, tres, hmeta};
    tail_gemm<MODE>(T, lds, tid);
}

__global__ void __launch_bounds__(512, 2) fwd_mega(Params P) {
    extern __shared__ __attribute__((aligned(16))) unsigned char lds[];
    cg::grid_group grid = cg::this_grid();
    const int G = gridDim.x, NGW = G * 8;
    if (threadIdx.x < 4) ((unsigned*)(lds + 131072))[threadIdx.x] = 0u;
    __syncthreads();
    (void)xcd_barrier_post((unsigned*)(P.ws + WS_BAR), (volatile LAS unsigned*)(lds + 131072));
    if (G == 0x7fffffff) grid.sync();

    {   PH_BEGIN();
        for (int it = gw; it < 16 * 136; it += NGW) transpose_item(P.in[3], 1024, 4112, 136, P.in[2], WIN, 0, scr, it, lane);
        {   const float* x_ = P.in[0]; const float* m_ = P.in[1];
            rms_rows_bf16([=](int r) { return r < MX ? x_ + (size_t)r * D : m_ + (size_t)((r - MX) & 15) * D; }, HN, MROWS, gw, NGW, lane); }
    }
    SEAM();
    {   PH_BEGIN();
        gemm_full<EM_PROJ>(lds, G, HN, WIN, 4096, 1024, QKVPRE, GATE, nullptr, nullptr, nullptr, AB, nullptr, HMETA, tid);
    }
    SEAM();
    {   PH_BEGIN();
        gdn_prep(lds, QKVPRE, AB, P.in[4], P.in[5], P.in[6], REC, EXPGL, tid, (int)blockIdx.x, NEARLY * 16, G, false, nullptr);
    }
    SEAM();
    {   PH_BEGIN();
        unsigned* FLAGS = (unsigned*)(ws + WS_FLAGS);
        if (blockIdx.x < 64) gdn_scan(lds, REC, EXPGL, QKVPRE  , tid, FLAGS);
        else {
            gdn_prep(lds, QKVPRE, AB, P.in[4], P.in[5], P.in[6], REC, EXPGL, tid, (int)blockIdx.x - 64, (NCH - NEARLY) * 16, G - 64, true, FLAGS);
            const int gw2 = (blockIdx.x - 64) * 8 + wid, NGW2 = (G - 64) * 8;
            for (int it = gw2; it < 11008; it += NGW2) {
                int r = it; const float* W; const float* gn = nullptr; int K = 1024, N = 1024, nblk = 32, mp = 0; size_t dst;
                if (r < 512) { W = P.in[8]; dst = W_OUT; }
                else if ((r -= 512) < 2816) { W = P.in[15]; N = 5632; nblk = 176; gn = P.in[14]; mp = 1; dst = W_GU0; }
                else if ((r -= 2816) < 1408) { W = P.in[16]; K = 2816; dst = W_D0; }
                else if ((r -= 1408) < 512) { W = P.in[12]; gn = P.in[11]; dst = W_QKV; }
                else if ((r -= 512) < 1024) { W = P.in[10]; N = 2048; nblk = 64; gn = P.in[9]; dst = W_QKV + (size_t)1024 * 1024 * 2; }
                else if ((r -= 1024) < 512) { W = P.in[13]; dst = W_O; }
                else if ((r -= 512) < 2816) { W = P.in[15] + (size_t)1024 * 5632; N = 5632; nblk = 176; gn = P.in[14] + 1024; mp = 1; dst = W_GU1; }
                else { r -= 2816; W = P.in[16] + (size_t)2816 * 1024; K = 2816; dst = W_D1; }
                transpose_item(W, K, N, nblk, gn, (bf16_t*)(ws + dst), mp, scr, r, lane);
            }
        }
    }
    SEAM();
    {   PH_BEGIN();
        og_phase(QKVPRE  , GATE, P.in[7], HN  , gw, NGW, lane);
    }
    SEAM();
    {   PH_BEGIN();
        gemm_full<EM_RES>(lds, G, HN, (const bf16_t*)(ws + W_OUT), 1024, 1024, nullptr, nullptr, nullptr, P.in[0], (float*)ws, nullptr, P.in[1], HMETA, tid);
    }
    SEAM();
#define NORM_PHASE() { PH_BEGIN(); rms_rows_h16(ws, HMETA, HN, gw, NGW, lane); }
    NORM_PHASE();
    SEAM();
    {   PH_BEGIN();
        gemm_full<EM_SWIGLU>(lds, G, HN, (const bf16_t*)(ws + W_GU0), 5632, 1024, ACT, nullptr, nullptr, nullptr, nullptr, nullptr, nullptr, HMETA, tid);
    }
    SEAM();
    {   PH_BEGIN();
        gemm_full<EM_RES>(lds, G, ACT, (const bf16_t*)(ws + W_D0), 1024, 2816, nullptr, nullptr, nullptr, nullptr, (float*)ws, nullptr, HMETA, HMETA, tid);
    }
    SEAM();
    NORM_PHASE();
    SEAM();
    {   PH_BEGIN();
        for (int i = blockIdx.x * 512 + tid; i < 32 * 64 * 16; i += G * 512) QKVPRE[vt_index(i >> 10, (i >> 4) & 63, LSEQ + (i & 15))] = 0;
        gemm_full<EM_QKV>(lds, G, HN, (const bf16_t*)(ws + W_QKV), 3072, 1024, ACT  , nullptr, QKVPRE  , nullptr, nullptr, nullptr, nullptr, HMETA, tid);
    }
    SEAM();
    {   PH_BEGIN();
        attn_phase(ACT  , QKVPRE  , HN  , gw, NGW, lane);
    }
    SEAM();
    {   PH_BEGIN();
        gemm_full<EM_RES>(lds, G, HN, (const bf16_t*)(ws + W_O), 1024, 1024, nullptr, nullptr, nullptr, nullptr, (float*)ws, nullptr, HMETA, HMETA, tid);
    }
    SEAM();
    NORM_PHASE();
    SEAM();
    {   PH_BEGIN();
        gemm_full<EM_SWIGLU>(lds, G, HN, (const bf16_t*)(ws + W_GU1), 5632, 1024, ACT, nullptr, nullptr, nullptr, nullptr, nullptr, nullptr, HMETA, tid);
    }
    SEAM();
    {   PH_BEGIN();
        gemm_full<EM_RES>(lds, G, ACT, (const bf16_t*)(ws + W_D1), 1024, 2816, nullptr, nullptr, nullptr, nullptr, (float*)ws, nullptr, HMETA, HMETA, tid);
    }
    SEAM();
    {   PH_BEGIN();
        const f32x4* gp = (const f32x4*)P.in[17] + lane;
        f32x4 gv[4]; u32x2 v[4], nv[4];
#pragma unroll
        for (int j = 0; j < 4; ++j) gv[j] = gp[64 * j];
        int r = gw;
        if (r < MX) { const u32x2* s = (const u32x2*)h16row(ws, r) + lane;
#pragma unroll
            for (int j = 0; j < 4; ++j) v[j] = s[64 * j]; }
        for (; r < MX; r += NGW) {
            if (r + NGW < MX) { const u32x2* s = (const u32x2*)h16row(ws, r + NGW) + lane;
#pragma unroll
                for (int j = 0; j < 4; ++j) nv[j] = s[64 * j]; }
            f32x4 f[4]; float ss = 0.f;
#pragma unroll
            for (int j = 0; j < 4; ++j) { f[j] = (f32x4){bflo(v[j].x), bfhi(v[j].x), bflo(v[j].y), bfhi(v[j].y)}; ss += (f[j].x * f[j].x + f[j].y * f[j].y) + (f[j].z * f[j].z + f[j].w * f[j].w); }
            const float rr = rsqrtf(wave_sum(ss) * (1.0f / 1024.0f) + EPS);
            f32x4* o = (f32x4*)(dout + (size_t)r * D) + lane;
#pragma unroll
            for (int j = 0; j < 4; ++j) o[64 * j] = f[j] * rr * gv[j];
#pragma unroll
            for (int j = 0; j < 4; ++j) v[j] = nv[j];
        }
    }
}

extern "C" void kernel_launch(void* const* d_in, const int* in_sizes, int n_in, void* d_out, int out_size, void* d_ws, size_t ws_size, hipStream_t stream) {
    static int grid_blocks = 0;
    if (grid_blocks == 0) {
        if (n_in != 18 || ws_size < WS_END) { fprintf(stderr, "kernel_launch: unexpected n_in %d / ws_size %zu (need %zu)\n", n_in, ws_size, (size_t)WS_END); grid_blocks = -1; return; }
        int dev = 0, cus = 0, per_cu = 0;
        hipGetDevice(&dev);
        hipDeviceGetAttribute(&cus, hipDeviceAttributeMultiprocessorCount, dev);
        if (hipFuncSetAttribute((const void*)fwd_mega, hipFuncAttributeMaxDynamicSharedMemorySize, LDS_BYTES) != hipSuccess) { fprintf(stderr, "kernel_launch: hipFuncSetAttribute failed\n"); grid_blocks = -1; return; }
        hipOccupancyMaxActiveBlocksPerMultiprocessor(&per_cu, (const void*)fwd_mega, 512, LDS_BYTES);
        if (per_cu < 1) { fprintf(stderr, "kernel_launch: occupancy query gave %d\n", per_cu); per_cu = 1; }
        grid_blocks = cus;
        if (grid_blocks < 128) { fprintf(stderr, "kernel_launch: only %d CUs\n", grid_blocks); grid_blocks = -1; return; }
    }
    if (grid_blocks < 0) return;
    if (hipMemsetAsync((unsigned char*)d_ws + WS_BAR, 0, 16384 + 8448, stream) != hipSuccess) { fprintf(stderr, "kernel_launch: memset of barrier words failed\n"); return; }
    Params p{};
    for (int i = 0; i < 18; ++i) p.in[i] = (const float*)d_in[i];
    p.out = (float*)d_out; p.ws = (unsigned char*)d_ws;
    void* args[] = {&p};
    hipError_t e = hipLaunchCooperativeKernel((const void*)fwd_mega, dim3(grid_blocks), dim3(512), args, LDS_BYTES, stream);
    if (e != hipSuccess) fprintf(stderr, "cooperative launch failed: %s (grid %d)\n", hipGetErrorString(e), grid_blocks);
}
```

```cpp
#include <hip/hip_runtime.h>
#include <hip/hip_cooperative_groups.h>
#include <cstdio>
#include <cstdint>
namespace cg = cooperative_groups;
namespace pg8 {
#define PG8_LAS __attribute__((address_space(3)))
typedef unsigned short bf16_t;
typedef short bf16x8 __attribute__((ext_vector_type(8)));
typedef float f32x4 __attribute__((ext_vector_type(4)));
typedef unsigned u32x4 __attribute__((ext_vector_type(4)));
constexpr int BM = 256, BK = 64, HALF = 128, HTB = HALF * BK * 2  , STAGE_BYTES = 8 * HTB, NXCD = 8, WGM = 4;

__host__ __device__ __forceinline__ int lds_byte(int r, int c) { const int st = (r >> 4) * 2 + (c >> 5), rr = r & 15, cc = c & 31, ob = rr * 64 + cc * 2; return st * 1024 + (ob ^ (((ob >> 9) & 1) << 5)); }
__host__ __device__ __forceinline__ void stage_rc(int b, int& R, int& C) { const int st = b / 1024, sb = b % 1024, swz = sb ^ (((sb >> 9) & 1) << 5); R = (st >> 1) * 16 + swz / 64; C = (st & 1) * 32 + (swz % 64) / 2; }
__host__ __device__ __forceinline__ int perm32(int rho) { const int n = rho >> 4, i = rho & 15; return 8 * (i >> 2) + 4 * n + (i & 3); }

struct Unit { int pm, pn; };
struct Gemm { const bf16_t* A; const bf16_t* Bt; int M, N, K; };

struct StaticOrder {
    int nM, nN, nwg, G, c;
    __host__ __device__ void init(int M, int N, int G_, int c_) { nM = M / BM; nN = N / BM; nwg = nM * nN; G = G_; c = c_; }
    __host__ __device__ bool next(int i, Unit& u) const {
        const long L = (long)i * G + c; if (L >= nwg) return false;
        int wgid = (int)L; { const int q = nwg / NXCD, r = nwg % NXCD, xcd = wgid % NXCD, off = wgid / NXCD; wgid = (xcd < r ? xcd * (q + 1) : r * (q + 1) + (xcd - r) * q) + off; }
        const int nig = WGM * nN, gid = wgid / nig, fm = gid * WGM, gsz = (nM - fm) < WGM ? (nM - fm) : WGM;
        u.pm = fm + ((wgid % nig) % gsz); u.pn = (wgid % nig) / gsz; return true;
    }
    __device__ __forceinline__ void a_ready(const Unit&) const {}
    __device__ __forceinline__ void done(const Unit&) const {}
};
template <class Epi, class Sched, bool ALIGN_EPI = false, bool SP2 = false>
__device__ __forceinline__ void gemm_phase(PG8_LAS unsigned char* lds, const Gemm g, const Sched& S, const Epi& E) {
    int tid_raw = threadIdx.x; asm volatile("" : "+v"(tid_raw));
    const int tid = tid_raw, wid = __builtin_amdgcn_readfirstlane(tid >> 6), lane = tid & 63, wr = wid >> 2, wc = wid & 3, fr = lane & 15, fq = lane >> 4;
    const int K = g.K, nt = K / BK;
    unsigned voffA[2], voffB[2];
#pragma unroll
    for (int i = 0; i < 2; ++i) { int R, C; stage_rc(tid * 16 + i * 8192, R, C); const int Rb = Epi::PERM ? ((R & ~31) + perm32(R & 31)) : R;
        voffA[i] = (unsigned)(R * K + C) * 2u; voffB[i] = (unsigned)(Rb * K + C) * 2u; }
    const size_t kstep = (size_t)(BK * 2);
    const size_t hstep = (size_t)HALF * K * 2;
    const size_t tstep = 2 * hstep;
    const unsigned ldsw = (unsigned)wid * 1024u;
    const int aoff = lds_byte(wr * 64 + fr, fq * 8), boff = lds_byte(wc * 32 + fr, fq * 8);
#define PG8_SA(b, h) (((b) * 2 + (h)) * HTB)
#define PG8_SB(b, h) ((4 + (b) * 2 + (h)) * HTB)
#define PG8_STAGE(bufoff, gbase, voff) do { _Pragma("unroll") for (int _i = 0; _i < 2; ++_i) \
        __builtin_amdgcn_global_load_lds((const unsigned*)((const char*)(gbase) + (voff)[_i]), (PG8_LAS unsigned*)(lds + (bufoff) + ldsw + _i * 8192), 16, 0, 0); } while (0)
#define PG8_LDA(dst, b, h) do { _Pragma("unroll") for (int m = 0; m < 4; ++m) _Pragma("unroll") for (int k = 0; k < 2; ++k) dst[m][k] = *(const PG8_LAS bf16x8*)(lds + PG8_SA(b, h) + aoff + m * 2048 + k * 1024); } while (0)
#define PG8_LDB(dst, b, h) do { _Pragma("unroll") for (int n = 0; n < 2; ++n) _Pragma("unroll") for (int k = 0; k < 2; ++k) dst[n][k] = *(const PG8_LAS bf16x8*)(lds + PG8_SB(b, h) + boff + n * 2048 + k * 1024); } while (0)
#define PG8_MMA(ai, bj, At, Bt) do { __builtin_amdgcn_s_setprio(1); _Pragma("unroll") for (int m = 0; m < 4; ++m) _Pragma("unroll") for (int n = 0; n < 2; ++n) _Pragma("unroll") for (int k = 0; k < 2; ++k) \
        acc[ai][bj][m][n] = __builtin_amdgcn_mfma_f32_16x16x32_bf16(Bt[n][k], At[m][k], acc[ai][bj][m][n], 0, 0, 0); __builtin_amdgcn_s_setprio(0); } while (0)
#define PG8_WAIT_V(n) asm volatile("s_waitcnt vmcnt(" #n ")" ::: "memory")
#define PG8_WAIT_L(n) asm volatile("s_waitcnt lgkmcnt(" #n ")" ::: "memory")
#define PG8_BAR __builtin_amdgcn_s_barrier()
#define PG8_SCHED __builtin_amdgcn_sched_barrier(0)
    Unit cur, nxt; int ui = 0;
    if (!S.next(0, cur)) return;
    f32x4 acc[2][2][4][2];
#pragma unroll
    for (int a = 0; a < 2; ++a)
#pragma unroll
        for (int b = 0; b < 2; ++b)
#pragma unroll
            for (int m = 0; m < 4; ++m)
#pragma unroll
                for (int n = 0; n < 2; ++n) acc[a][b][m][n] = (f32x4){0.f, 0.f, 0.f, 0.f};
    bf16x8 At[4][2], B0[2][2], B1[2][2];
    const char* cA = (const char*)g.A + (size_t)cur.pm * tstep; const char* cB = (const char*)g.Bt + (size_t)cur.pn * tstep;
    S.a_ready(cur);
    if constexpr (SP2) {
        PG8_STAGE(PG8_SB(0, 0), cB, voffB); PG8_STAGE(PG8_SB(0, 1), cB + hstep, voffB); PG8_STAGE(PG8_SA(0, 0), cA, voffA); PG8_STAGE(PG8_SA(0, 1), cA + hstep, voffA);
        if (wr == 1) PG8_BAR;
        PG8_WAIT_V(2); PG8_BAR;
        PG8_STAGE(PG8_SB(1, 0), cB + kstep, voffB); PG8_STAGE(PG8_SA(1, 0), cA + kstep, voffA); PG8_STAGE(PG8_SB(1, 1), cB + hstep + kstep, voffB);
        PG8_WAIT_V(6); PG8_BAR;
    } else {
        PG8_STAGE(PG8_SB(0, 0), cB, voffB); PG8_STAGE(PG8_SA(0, 0), cA, voffA); PG8_STAGE(PG8_SB(0, 1), cB + hstep, voffB); PG8_STAGE(PG8_SA(0, 1), cA + hstep, voffA);
        if (wr == 1) PG8_BAR;
        PG8_WAIT_V(4); PG8_BAR;
        PG8_STAGE(PG8_SB(1, 0), cB + kstep, voffB); PG8_STAGE(PG8_SA(1, 0), cA + kstep, voffA); PG8_STAGE(PG8_SB(1, 1), cB + hstep + kstep, voffB);
        PG8_WAIT_V(6); PG8_BAR;
    }
    for (;;) {
        const bool has_next = S.next(ui + 1, nxt);
        const char* nA = has_next ? (const char*)g.A + (size_t)nxt.pm * tstep : cA; const char* nB = has_next ? (const char*)g.Bt + (size_t)nxt.pn * tstep : cB;
        for (int t = 0; t < nt; t += 2) {
            const bool last = (t == nt - 2);
            const char* a1 = cA + (size_t)(t + 1) * kstep;
            const char* a2 = last ? nA : cA + (size_t)(t + 2) * kstep; const char* b2 = last ? nB : cB + (size_t)(t + 2) * kstep;
            const char* a3 = a2 + kstep; const char* b3 = b2 + kstep;
            if (last && has_next) S.a_ready(nxt);
            if constexpr (SP2) {
            PG8_LDB(B0, 0, 0); PG8_LDB(B1, 0, 1); PG8_SCHED; PG8_LDA(At, 0, 0); PG8_STAGE(PG8_SA(1, 1), a1 + hstep, voffA);
            PG8_WAIT_V(8); PG8_WAIT_L(0); PG8_BAR; PG8_MMA(0, 0, At, B0); PG8_MMA(0, 1, At, B1); PG8_BAR; PG8_SCHED;
            PG8_LDA(At, 0, 1); PG8_STAGE(PG8_SB(0, 0), b2, voffB); PG8_STAGE(PG8_SB(0, 1), b2 + hstep, voffB); PG8_STAGE(PG8_SA(0, 0), a2, voffA);
            PG8_WAIT_V(8); PG8_WAIT_L(0); PG8_BAR; PG8_MMA(1, 0, At, B0); PG8_MMA(1, 1, At, B1); PG8_BAR; PG8_SCHED;
            PG8_LDB(B0, 1, 0); PG8_LDB(B1, 1, 1); PG8_SCHED; PG8_LDA(At, 1, 0); PG8_STAGE(PG8_SA(0, 1), a2 + hstep, voffA);
            PG8_WAIT_V(8); PG8_WAIT_L(0); PG8_BAR; PG8_MMA(0, 0, At, B0); PG8_MMA(0, 1, At, B1); PG8_BAR; PG8_SCHED;
            PG8_LDA(At, 1, 1); PG8_STAGE(PG8_SB(1, 0), b3, voffB); PG8_STAGE(PG8_SB(1, 1), b3 + hstep, voffB); PG8_STAGE(PG8_SA(1, 0), a3, voffA);
            PG8_WAIT_V(8); PG8_WAIT_L(0); PG8_BAR; PG8_MMA(1, 0, At, B0); PG8_MMA(1, 1, At, B1); PG8_BAR; PG8_SCHED;
            } else {
            PG8_LDB(B0, 0, 0); PG8_SCHED; PG8_LDA(At, 0, 0); PG8_STAGE(PG8_SA(1, 1), a1 + hstep, voffA);
            PG8_WAIT_L(8); PG8_BAR; PG8_WAIT_L(0); PG8_MMA(0, 0, At, B0); PG8_BAR; PG8_SCHED;
            PG8_LDB(B1, 0, 1); PG8_STAGE(PG8_SB(0, 0), b2, voffB);
            PG8_BAR; PG8_WAIT_L(0); PG8_MMA(0, 1, At, B1); PG8_BAR;
            PG8_LDA(At, 0, 1); PG8_STAGE(PG8_SA(0, 0), a2, voffA);
            PG8_BAR; PG8_WAIT_L(0); PG8_MMA(1, 0, At, B0); PG8_BAR; PG8_SCHED;
            PG8_STAGE(PG8_SB(0, 1), b2 + hstep, voffB);
            PG8_WAIT_V(6); PG8_BAR; PG8_MMA(1, 1, At, B1); PG8_BAR;
            PG8_LDB(B0, 1, 0); PG8_SCHED; PG8_LDA(At, 1, 0); PG8_STAGE(PG8_SA(0, 1), a2 + hstep, voffA);
            PG8_WAIT_L(8); PG8_BAR; PG8_WAIT_L(0); PG8_MMA(0, 0, At, B0); PG8_BAR; PG8_SCHED;
            PG8_LDB(B1, 1, 1); PG8_STAGE(PG8_SB(1, 0), b3, voffB);
            PG8_BAR; PG8_WAIT_L(0); PG8_MMA(0, 1, At, B1); PG8_BAR;
            PG8_LDA(At, 1, 1); PG8_STAGE(PG8_SA(1, 0), a3, voffA);
            PG8_BAR; PG8_WAIT_L(0); PG8_MMA(1, 0, At, B0); PG8_BAR; PG8_SCHED;
            PG8_STAGE(PG8_SB(1, 1), b3 + hstep, voffB);
            PG8_WAIT_V(6); PG8_BAR; PG8_MMA(1, 1, At, B1); PG8_BAR;
            }
        }
        if constexpr (ALIGN_EPI) { if (wr == 0) PG8_BAR; }
        if constexpr (!Epi::AFTER_DRAIN) { E(acc, cur, wr, wc, fr, fq); S.done(cur); }
        if (!has_next) break;
#pragma unroll
        for (int a = 0; a < 2; ++a)
#pragma unroll
            for (int b = 0; b < 2; ++b)
#pragma unroll
                for (int m = 0; m < 4; ++m)
#pragma unroll
                    for (int n = 0; n < 2; ++n) acc[a][b][m][n] = (f32x4){0.f, 0.f, 0.f, 0.f};
        cur = nxt; cA = nA; cB = nB; ++ui;
        if constexpr (ALIGN_EPI) { if (wr == 1) PG8_BAR; }
    }
    PG8_WAIT_V(0);
    if constexpr (!ALIGN_EPI) { if (wr == 0) PG8_BAR; }
    PG8_BAR;
    if constexpr (Epi::AFTER_DRAIN) { E.fused(acc, cur, wr, wc, fr, fq, lds, wid, lane); S.done(cur); }
#undef PG8_SA
#undef PG8_SB
#undef PG8_STAGE
#undef PG8_LDA
#undef PG8_LDB
#undef PG8_MMA
#undef PG8_WAIT_V
#undef PG8_WAIT_L
#undef PG8_BAR
#undef PG8_SCHED
}
}

using pg8::bf16_t; using pg8::bf16x8; using pg8::f32x4; using pg8::u32x4;
typedef float f32x16 __attribute__((ext_vector_type(16)));
typedef float f32x8 __attribute__((ext_vector_type(8)));
typedef unsigned u32x2 __attribute__((ext_vector_type(2)));

constexpr int D = 1024, SEQ = 8192, NB = 2, NMETA = 16, LSEQ = SEQ + NMETA, MX = NB * SEQ, MROWS = MX + NB * NMETA;
constexpr int NEARLY = 96;
constexpr int DFF = 2816, NCH = 129, LP = NCH * 64, NREC = 16 * NCH;
constexpr float EPS = 1e-6f;
constexpr int REC_BYTES = 73728;
constexpr size_t WS_WIN = 0;
constexpr size_t WS_REC = 8912896;
constexpr size_t HN_BYTES = (size_t)MROWS * 1024 * 2;
constexpr size_t WS_R4 = WS_REC + (size_t)NREC * REC_BYTES;
constexpr size_t OBUF_BYTES = (size_t)16 * LP * 128 * 2;
constexpr size_t WS_W2 = WS_R4 + OBUF_BYTES;
constexpr size_t W_OUT = WS_W2, W_GU0 = WS_R4 + 50331648, W_QKV = W_GU0 + 11534336, W_O = W_QKV + 6291456, W_GU1 = W_O + 2097152, W_D1 = W_GU1 + 11534336, W_END = W_D1 + 5767168;
static_assert(W_OUT + 2097152 <= WS_R4 + 37337088 && W_END <= WS_R4 + 87668736, "weight copies vs late qkvpre rows");
constexpr size_t WS_MISC = WS_R4 + (size_t)MROWS * 3072 * 2;
constexpr size_t WS_HMETA = WS_MISC, WS_EXPGL = WS_MISC + 131072, WS_BAR = WS_EXPGL + 8448, WS_FLAGS = WS_BAR + 16384, W_D0 = WS_FLAGS + 8448, WS_END = W_D0 + 5767168;
static_assert(WS_END <= 268435456ull, "workspace");
constexpr int LDS_BYTES = 131072 + 16;

constexpr size_t WS_H16A = 8912896 + (size_t)33619968 + (size_t)92454912, H16_SPLIT = 12288;
__device__ __forceinline__ bf16_t* h16row(unsigned char* ws, int r) { return (bf16_t*)(ws + (r < (int)H16_SPLIT ? WS_H16A + (size_t)r * 2048 : (size_t)(r - (int)H16_SPLIT) * 2048)); }
__device__ __forceinline__ size_t vt_index(int bh, int d, int p) { return (((size_t)bh * (LP / 32) + (p >> 5)) * 64 + d) * 32 + (p & 31); }
__device__ __forceinline__ int rowof(int b, int p) { return p < NMETA ? MX + b * NMETA + p : b * SEQ + p - NMETA; }
typedef __bf16 bf16x2_t __attribute__((ext_vector_type(2)));
typedef float f32x2_t __attribute__((ext_vector_type(2)));
__device__ __forceinline__ unsigned pk2(float lo, float hi) { const f32x2_t v = {lo, hi}; const bf16x2_t b = __builtin_convertvector(v, bf16x2_t); return __builtin_bit_cast(unsigned, b); }
__device__ __forceinline__ bf16_t f2bf(float x) { return (bf16_t)(pk2(x, 0.f) & 0xffffu); }
__device__ __forceinline__ float bf2f(unsigned short v) { return __uint_as_float(((unsigned)v) << 16); }
__device__ __forceinline__ float bflo(unsigned w) { return __uint_as_float(w << 16); }
__device__ __forceinline__ float bfhi(unsigned w) { return __uint_as_float(w & 0xffff0000u); }
__device__ __forceinline__ float wave_sum(float v) {
#pragma unroll
    for (int o = 1; o < 64; o <<= 1) v += __shfl_xor(v, o);
    return v;
}
__device__ __forceinline__ float siluf(float x) { return x * __frcp_rn(1.0f + __expf(-x)); }
__device__ __forceinline__ f32x4 mfma16(bf16x8 a, bf16x8 b, f32x4 c) { return __builtin_amdgcn_mfma_f32_16x16x32_bf16(a, b, c, 0, 0, 0); }
__device__ __forceinline__ f32x16 mfma32(bf16x8 a, bf16x8 b, f32x16 c) { return __builtin_amdgcn_mfma_f32_32x32x16_bf16(a, b, c, 0, 0, 0); }
__device__ __forceinline__ bf16x8 as_bf16x8(u32x4 v) { union { u32x4 u; bf16x8 b; } x; x.u = v; return x.b; }
__device__ __forceinline__ bf16x8 pack8(f32x4 x, f32x4 y) { u32x4 v; v.x = pk2(x[0], x[1]); v.y = pk2(x[2], x[3]); v.z = pk2(y[0], y[1]); v.w = pk2(y[2], y[3]); return as_bf16x8(v); }
#define LDSWAIT() asm volatile("s_waitcnt lgkmcnt(0)" ::: "memory")

enum { EM_PROJ = 0, EM_QKV = 1, EM_SWIGLU = 2, EM_RES = 3 };
template <int mode> struct EpiUni {
    static constexpr bool PERM = true, AFTER_DRAIN = false;
    bf16_t* o0; bf16_t* o1; bf16_t* vt; const float* res; float* outf;
    __device__ __forceinline__ void operator()(const f32x4 (&acc)[2][2][4][2], const pg8::Unit& u, int wr, int wc, int fr, int fq) const {
        const int row0 = u.pm * 256 + wr * 64 + fr, ct = u.pn * 256 + wc * 32 + 8 * fq;
        if (mode == EM_SWIGLU) {
            const int col = u.pn * 128 + wc * 32 + 8 * fq;
#pragma unroll
            for (int ai = 0; ai < 2; ++ai)
#pragma unroll
                for (int m = 0; m < 4; ++m) {
                    const int row = row0 + ai * 128 + m * 16; float v[8];
#pragma unroll
                    for (int e = 0; e < 8; ++e) v[e] = siluf(acc[ai][0][m][e >> 2][e & 3]) * acc[ai][1][m][e >> 2][e & 3];
                    u32x4 w; w.x = pk2(v[0], v[1]); w.y = pk2(v[2], v[3]); w.z = pk2(v[4], v[5]); w.w = pk2(v[6], v[7]);
                    *(u32x4*)(o0 + (size_t)row * DFF + col) = w;
                    asm volatile("" ::: "memory");
                }
        } else if (mode == EM_RES) {
#pragma unroll
            for (int ai = 0; ai < 2; ++ai)
#pragma unroll
                for (int m = 0; m < 4; ++m) {
                    const int row = row0 + ai * 128 + m * 16;
                    bf16_t* hp = h16row((unsigned char*)outf, row) + ct;
#pragma unroll
                    for (int bj = 0; bj < 2; ++bj) {
                        f32x4 r0, r1;
                        if (res) { r0 = *(const f32x4*)(res + (size_t)row * D + ct + bj * 128); r1 = *(const f32x4*)(res + (size_t)row * D + ct + bj * 128 + 4); }
                        else { const u32x4 hv = *(const u32x4*)(hp + bj * 128); r0 = (f32x4){bflo(hv.x), bfhi(hv.x), bflo(hv.y), bfhi(hv.y)}; r1 = (f32x4){bflo(hv.z), bfhi(hv.z), bflo(hv.w), bfhi(hv.w)}; }
                        const f32x4 o0v = r0 + acc[ai][bj][m][0], o1v = r1 + acc[ai][bj][m][1];
                        u32x4 w; w.x = pk2(o0v.x, o0v.y); w.y = pk2(o0v.z, o0v.w); w.z = pk2(o1v.x, o1v.y); w.w = pk2(o1v.z, o1v.w);
                        *(u32x4*)(hp + bj * 128) = w;
                    }
                    asm volatile("" ::: "memory");
                }
        } else {
            const bool gatecols = (mode == EM_PROJ) && (u.pn >= 12);
            bf16_t* const p0 = o0; bf16_t* const p1 = o1;
            bf16_t* const base = gatecols ? p1 : p0;
            const int ldc = (mode == EM_PROJ) ? (gatecols ? 1024 : 3072) : 2048, cb = gatecols ? ct - 3072 : ct;
            const bool tr = (mode == EM_QKV) && (u.pn >= 8);
            if (!tr) {
#pragma unroll
                for (int ai = 0; ai < 2; ++ai)
#pragma unroll
                    for (int m = 0; m < 4; ++m) {
                        bf16_t* rp = base + (size_t)(row0 + ai * 128 + m * 16) * ldc + cb;
#pragma unroll
                        for (int bj = 0; bj < 2; ++bj) {
                            const f32x4 v0 = acc[ai][bj][m][0], v1 = acc[ai][bj][m][1];
                            u32x4 w; w.x = pk2(v0[0], v0[1]); w.y = pk2(v0[2], v0[3]); w.z = pk2(v1[0], v1[1]); w.w = pk2(v1[2], v1[3]);
                            *(u32x4*)(rp + bj * 128) = w;
                        }
                    }
            } else {
#pragma unroll
                for (int ai = 0; ai < 2; ++ai)
#pragma unroll
                    for (int m = 0; m < 4; ++m) {
                        const int row = row0 + ai * 128 + m * 16, b = row >> 13, p = (row & 8191) + NMETA;
#pragma unroll
                        for (int bj = 0; bj < 2; ++bj)
#pragma unroll
                            for (int e = 0; e < 8; ++e) {
                                const int cv = ct + bj * 128 - 2048 + e;
                                vt[vt_index(b * 16 + (cv >> 6), cv & 63, p)] = f2bf(acc[ai][bj][m][e >> 2][e & 3]);
                            }
                    }
            }
        }
    }
};

template <int NIT> __device__ __forceinline__ f32x4 tail_dot(const bf16_t* a, const bf16_t* b) {
    bf16x8 av[NIT], bv[NIT];
#pragma unroll
    for (int i = 0; i < NIT; ++i) { av[i] = *(const bf16x8*)(a + 32 * i); bv[i] = *(const bf16x8*)(b + 32 * i); }
    f32x4 acc = {0.f, 0.f, 0.f, 0.f};
#pragma unroll
    for (int i = 0; i < NIT; ++i) acc = mfma16(av[i], bv[i], acc);
    return acc;
}
struct TailP { const bf16_t* A; const bf16_t* Bt; int K; bf16_t* o0; bf16_t* o1; bf16_t* vt; float* ab; const float* res; float* outf; };
template <int MODE> __device__ __forceinline__ void tail_gemm(const TailP& T, unsigned char* lds, int tid) {
    const int lane = tid & 63, wid = __builtin_amdgcn_readfirstlane(tid >> 6), fr = lane & 15, fq = lane >> 4;
    const int nct = MODE == EM_PROJ ? 257 : MODE == EM_QKV ? 192 : MODE == EM_SWIGLU ? 176 : 64;
    const int ntile = 2 * nct + (MODE == EM_PROJ ? 1024 : 0);
    f32x4* red = (f32x4*)lds;
    const int ks = T.K >> 3;
    const int vblk = (MODE == EM_SWIGLU) ? (int)((blockIdx.x + gridDim.x / 2) % gridDim.x) : (int)blockIdx.x;
    for (int t = vblk; t < ntile; t += gridDim.x) {
        int rbase, ct;
        if (t < 2 * nct) { rbase = MX + (t & 1) * 16; ct = t >> 1; } else { rbase = (t - 2 * nct) * 16; ct = 256; }
        const bf16_t* ap = T.A + (size_t)(rbase + fr) * T.K + wid * ks + fq * 8;
        const int c0 = ct * 16;
        const int brow = (MODE == EM_SWIGLU) ? (c0 >> 7) * 256 + (c0 & 127) + fr : c0 + fr;
        const bf16_t* bp = T.Bt + (size_t)brow * T.K + wid * ks + fq * 8;
        if (T.K == 1024) red[wid * 64 + lane] = tail_dot<4>(ap, bp); else red[wid * 64 + lane] = tail_dot<11>(ap, bp);
        if (MODE == EM_SWIGLU) red[512 + wid * 64 + lane] = tail_dot<4>(ap, bp + (size_t)128 * T.K);
        __syncthreads();
        if (wid == 0) {
            f32x4 acc = red[lane];
#pragma unroll
            for (int w = 1; w < 8; ++w) acc += red[w * 64 + lane];
            const int col = c0 + fr;
            if (MODE == EM_SWIGLU) {
                f32x4 up = red[512 + lane];
#pragma unroll
                for (int w = 1; w < 8; ++w) up += red[512 + w * 64 + lane];
#pragma unroll
                for (int j = 0; j < 4; ++j) T.o0[(size_t)(rbase + fq * 4 + j) * DFF + col] = f2bf(siluf(acc[j]) * up[j]);
            } else {
#pragma unroll
                for (int j = 0; j < 4; ++j) {
                    const int row = rbase + fq * 4 + j;
                    if (MODE == EM_RES) { const int mr = row - MX; T.outf[mr * D + col] = T.res[(T.res == T.outf ? mr : (mr & 15)) * D + col] + acc[j]; }
                    else if (MODE == EM_PROJ) {
                        if (col < 3072) T.o0[(size_t)row * 3072 + col] = f2bf(acc[j]);
                        else if (col < 4096) T.o1[(size_t)row * 1024 + col - 3072] = f2bf(acc[j]);
                        else T.ab[(size_t)row * 16 + col - 4096] = acc[j];
                    } else {
                        if (col < 2048) T.o0[(size_t)row * 2048 + col] = f2bf(acc[j]);
                        else { const int cv = col - 2048, b = (row - MX) >> 4, p = (row - MX) & 15; T.vt[vt_index(b * 16 + (cv >> 6), cv & 63, p)] = f2bf(acc[j]); }
                    }
                }
            }
        }
        __syncthreads();
    }
}

__device__ __forceinline__ void transpose_item(const float* W, int K, int N, int nblk, const float* gain, bf16_t* WT, int mapmode, float* scr, int item, int lane) {
    const int kb = item / nblk, nb = item % nblk, k0 = 64 * kb, n0 = 32 * nb;
    const int nn = n0 + (lane & 31);
#pragma unroll 8
    for (int i = 0; i < 32; ++i) {
        const int kk = 2 * i + (lane >> 5);
        float v = 0.f;
        if (nn < N) v = W[(size_t)(k0 + kk) * N + nn] * (gain ? gain[k0 + kk] : 1.0f);
        scr[kk * 33 + (lane & 31)] = v;
    }
    LDSWAIT();
    int d0 = n0;
    if (mapmode == 1) d0 = n0 < DFF ? (n0 >> 7) * 256 + (n0 & 127) : ((n0 - DFF) >> 7) * 256 + 128 + ((n0 - DFF) & 127);
    const int c = lane & 7;
#pragma unroll
    for (int j = 0; j < 4; ++j) {
        const int n = (lane >> 3) + 8 * j; const float* s = scr + (8 * c) * 33 + n;
        u32x4 o; o.x = pk2(s[0 * 33], s[1 * 33]); o.y = pk2(s[2 * 33], s[3 * 33]); o.z = pk2(s[4 * 33], s[5 * 33]); o.w = pk2(s[6 * 33], s[7 * 33]);
        *(u32x4*)(WT + (size_t)(d0 + n) * K + k0 + 8 * c) = o;
    }
    LDSWAIT();
}

template <class SrcFn> __device__ __forceinline__ void rms_rows_bf16(SrcFn src, bf16_t* dst, int nrows, int gw, int NGW, int lane) {
    f32x4 v[4], nv[4];
    int r = gw;
    if (r < nrows) { const f32x4* s = (const f32x4*)src(r) + lane;
#pragma unroll
        for (int j = 0; j < 4; ++j) v[j] = s[64 * j]; }
    for (; r < nrows; r += NGW) {
        const int rn = r + NGW;
        if (rn < nrows) { const f32x4* s = (const f32x4*)src(rn) + lane;
#pragma unroll
            for (int j = 0; j < 4; ++j) nv[j] = s[64 * j]; }
        float ss = 0.f;
#pragma unroll
        for (int j = 0; j < 4; ++j) ss += (v[j].x * v[j].x + v[j].y * v[j].y) + (v[j].z * v[j].z + v[j].w * v[j].w);
        const float rr = rsqrtf(wave_sum(ss) * (1.0f / 1024.0f) + EPS);
        u32x2* o = (u32x2*)(dst + (size_t)r * D) + lane;
#pragma unroll
        for (int j = 0; j < 4; ++j) { u32x2 w; w.x = pk2(v[j].x * rr, v[j].y * rr); w.y = pk2(v[j].z * rr, v[j].w * rr); o[64 * j] = w; }
#pragma unroll
        for (int j = 0; j < 4; ++j) v[j] = nv[j];
    }
}
__device__ __forceinline__ void rms_row_bf16(const float* src, bf16_t* dst, int lane) {
    const f32x4* s = (const f32x4*)src + lane; f32x4 v[4]; float ss = 0.f;
#pragma unroll
    for (int j = 0; j < 4; ++j) { v[j] = s[64 * j]; ss += (v[j].x * v[j].x + v[j].y * v[j].y) + (v[j].z * v[j].z + v[j].w * v[j].w); }
    const float r = rsqrtf(wave_sum(ss) * (1.0f / 1024.0f) + EPS);
    u32x2* o = (u32x2*)dst + lane;
#pragma unroll
    for (int j = 0; j < 4; ++j) { u32x2 w; w.x = pk2(v[j].x * r, v[j].y * r); w.y = pk2(v[j].z * r, v[j].w * r); o[64 * j] = w; }
}
__device__ __forceinline__ void rms_rows_h16(unsigned char* ws, const float* hmeta, bf16_t* dst, int gw, int NGW, int lane) {
    u32x4 v[2], nv[2];
    int r = gw;
    if (r < MX) { const u32x4* s = (const u32x4*)h16row(ws, r) + lane; v[0] = s[0]; v[1] = s[64]; }
    for (; r < MX; r += NGW) {
        if (r + NGW < MX) { const u32x4* s = (const u32x4*)h16row(ws, r + NGW) + lane; nv[0] = s[0]; nv[1] = s[64]; }
        float f[16]; float ss = 0.f;
#pragma unroll
        for (int j = 0; j < 2; ++j) { f[8 * j] = bflo(v[j].x); f[8 * j + 1] = bfhi(v[j].x); f[8 * j + 2] = bflo(v[j].y); f[8 * j + 3] = bfhi(v[j].y);
                                      f[8 * j + 4] = bflo(v[j].z); f[8 * j + 5] = bfhi(v[j].z); f[8 * j + 6] = bflo(v[j].w); f[8 * j + 7] = bfhi(v[j].w); }
#pragma unroll
        for (int e = 0; e < 16; ++e) ss += f[e] * f[e];
        const float rr = rsqrtf(wave_sum(ss) * (1.0f / 1024.0f) + EPS);
        u32x4* o = (u32x4*)(dst + (size_t)r * D) + lane;
#pragma unroll
        for (int j = 0; j < 2; ++j) { u32x4 w; w.x = pk2(f[8 * j] * rr, f[8 * j + 1] * rr); w.y = pk2(f[8 * j + 2] * rr, f[8 * j + 3] * rr);
                                      w.z = pk2(f[8 * j + 4] * rr, f[8 * j + 5] * rr); w.w = pk2(f[8 * j + 6] * rr, f[8 * j + 7] * rr); o[64 * j] = w; }
        v[0] = nv[0]; v[1] = nv[1];
    }
    for (r = MX + gw; r < MROWS; r += NGW) rms_row_bf16(hmeta + (size_t)(r - MX) * D, dst + (size_t)r * D, lane);
}

__device__ __forceinline__ u32x4 ld_row8_raw(const bf16_t* base, int b, int p, int col) {
    u32x4 v = {0u, 0u, 0u, 0u};
    if (p >= 0) v = *(const u32x4*)(base + (size_t)rowof(b, p) * 3072 + col);
    return v;
}
__device__ __forceinline__ f32x8 cvt_row8(u32x4 v) {
    f32x8 r; r[0] = bflo(v.x); r[1] = bfhi(v.x); r[2] = bflo(v.y); r[3] = bfhi(v.y); r[4] = bflo(v.z); r[5] = bfhi(v.z); r[6] = bflo(v.w); r[7] = bfhi(v.w); return r;
}
__device__ __forceinline__ f32x8 ld_row8(const bf16_t* base, int b, int p, int col) {
    f32x8 r = {0.f, 0.f, 0.f, 0.f, 0.f, 0.f, 0.f, 0.f};
    if (p >= 0) {
        const u32x4 v = *(const u32x4*)(base + (size_t)rowof(b, p) * 3072 + col);
        r[0] = bflo(v.x); r[1] = bfhi(v.x); r[2] = bflo(v.y); r[3] = bfhi(v.y); r[4] = bflo(v.z); r[5] = bfhi(v.z); r[6] = bflo(v.w); r[7] = bfhi(v.w);
    }
    return r;
}
__device__ __forceinline__ int kperm(int k) { const int kk = k & 31; return (k & ~31) + ((kk >> 2) & 3) * 8 + ((kk >> 4) << 2) + (kk & 3); }
__device__ __forceinline__ int uperm(int m) { return (m & 3) * 8 + (m >> 2) * 4; }
__device__ __forceinline__ void gdn_prep(unsigned char* lds, const bf16_t* qkvpre, const float* ab, const float* conv_w, const float* a_log,
                                         const float* dt_bias, unsigned char* rec, float* expgl, int tid0, int it0, int itn, int itstep, bool late, unsigned* flags) {
    bf16_t* Qn = (bf16_t*)(lds);
    bf16_t* Kn = (bf16_t*)(lds + 17408);
    constexpr int XS = 144;
    float* Kf = (float*)(lds + 34816);
    float* Vf = (float*)(lds + 71680);
    float* Am = (float*)(lds + 108544);
    float* Gs = (float*)(lds + 124928);
    float* Td = (float*)(lds + 125696);
    float* Bs = Gs + 64; float* Es = Gs + 128;
    u32x4 raw[11]; float pf_a = 0.f, pf_b = 0.f;
#define PREP_PREFETCH(it_) do { if ((it_) < itn) { const int bh_ = late ? ((it_) & 15) : (it_) / NEARLY, n_ = late ? NEARLY + ((it_) >> 4) : (it_) % NEARLY, b_ = bh_ >> 3, h_ = bh_ & 7; \
        if (tid < 384) { const int cgi_ = tid % 48, ts_ = tid / 48; const int col_ = (cgi_ >> 4) * 1024 + h_ * 128 + (cgi_ & 15) * 8, p0_ = n_ * 64 - 48 + ts_ * 8; \
            _Pragma("unroll") for (int q = 0; q < 11; ++q) raw[q] = ld_row8_raw(qkvpre, b_, p0_ - 3 + q, col_); } \
        if (tid < 64) { const int p_ = n_ * 64 - 48 + tid; pf_a = 0.f; pf_b = 0.f; if (p_ >= 0) { const int row_ = rowof(b_, p_); pf_a = ab[(size_t)row_ * 16 + h_]; pf_b = ab[(size_t)row_ * 16 + 8 + h_]; } } } } while (0)
    { int tid = tid0; asm volatile("" : "+v"(tid)); PREP_PREFETCH(it0); }
    for (int it = it0; it < itn; it += itstep) {
        int tid = tid0; asm volatile("" : "+v"(tid));
        const int lane = tid & 63, wid = __builtin_amdgcn_readfirstlane(tid >> 6);
        const int bh = late ? (it & 15) : it / NEARLY, n = late ? NEARLY + (it >> 4) : it % NEARLY, b = bh >> 3, h = bh & 7;
        const int ridx = bh * NCH + n;
        unsigned char* R = rec + (size_t)ridx * REC_BYTES;
        if (wid == 0) {
            const int p = n * 64 - 48 + lane;
            float g = 0.f, be = 0.f;
            if (p >= 0) {
                const float a = pf_a, bb = pf_b;
                const float x = a + dt_bias[h];
                const float sp = fmaxf(x, 0.f) + __logf(1.0f + __expf(-fabsf(x)));
                g = -__expf(a_log[h]) * sp; be = 1.0f / (1.0f + __expf(-bb));
            }
            float G = g;
#pragma unroll
            for (int o = 1; o < 64; o <<= 1) { const float t = __shfl_up(G, o); if (lane >= o) G += t; }
            Gs[lane] = G; Bs[lane] = be; Es[lane] = __expf(G);
            if (lane == 63) expgl[ridx] = __expf(G);
        }
        __syncthreads();
#ifndef REP1
#define REP1 1
#endif
        if (tid < 384) {
            const int cgi = tid % 48, ts = tid / 48, sec = cgi >> 4, c0 = (cgi & 15) * 8;
            const int col = sec * 1024 + h * 128 + c0;
            f32x8 w0, w1, w2, w3;
            { const f32x4* wp = (const f32x4*)(conv_w + col);
              const f32x4 a0 = wp[0], a1 = wp[1], b0 = wp[768], b1 = wp[769], c0v = wp[1536], c1v = wp[1537], d0 = wp[2304], d1 = wp[2305];
              w0 = (f32x8){a0.x, a0.y, a0.z, a0.w, a1.x, a1.y, a1.z, a1.w}; w1 = (f32x8){b0.x, b0.y, b0.z, b0.w, b1.x, b1.y, b1.z, b1.w};
              w2 = (f32x8){c0v.x, c0v.y, c0v.z, c0v.w, c1v.x, c1v.y, c1v.z, c1v.w}; w3 = (f32x8){d0.x, d0.y, d0.z, d0.w, d1.x, d1.y, d1.z, d1.w}; }
            f32x8 x0 = cvt_row8(raw[0]), x1 = cvt_row8(raw[1]), x2 = cvt_row8(raw[2]);
#pragma unroll
            for (int tt = 0; tt < 8; ++tt) {
                const int i = ts * 8 + tt;
                const f32x8 x3 = cvt_row8(raw[3 + tt]);
                f32x8 y = w0 * x0 + w1 * x1 + w2 * x2 + w3 * x3;
                float ss = 0.f;
#pragma unroll
                for (int e = 0; e < 8; ++e) { y[e] = siluf(y[e]); ss += y[e] * y[e]; }
                ss += __shfl_xor(ss, 1); ss += __shfl_xor(ss, 2); ss += __shfl_xor(ss, 4); ss += __shfl_xor(ss, 8);
                if (sec == 0) {
                    const float r = rsqrtf(ss + EPS) * 0.08838834764831845f;
                    y = y * r;
                    u32x4 w; w.x = pk2(y[0], y[1]); w.y = pk2(y[2], y[3]); w.z = pk2(y[4], y[5]); w.w = pk2(y[6], y[7]);
                    *(u32x4*)(Qn + i * 136 + c0) = w;
                    const float eg = Es[i]; y = y * eg;
                    w.x = pk2(y[0], y[1]); w.y = pk2(y[2], y[3]); w.z = pk2(y[4], y[5]); w.w = pk2(y[6], y[7]);
                    {   const int blk = c0 & ~31, m0 = (c0 & 31) >> 2; u32x2 wa, wb; wa.x = w.x; wa.y = w.y; wb.x = w.z; wb.y = w.w;
                        *(u32x2*)(R + 16384 + (i * 128 + blk + uperm(m0)) * 2) = wa; *(u32x2*)(R + 16384 + (i * 128 + blk + uperm(m0 + 1)) * 2) = wb; }
                } else if (sec == 1) {
                    const float r = rsqrtf(ss + EPS);
                    y = y * r;
                    u32x4 w; w.x = pk2(y[0], y[1]); w.y = pk2(y[2], y[3]); w.z = pk2(y[4], y[5]); w.w = pk2(y[6], y[7]);
                    *(u32x4*)(Kn + i * 136 + c0) = w;
                    *(f32x4*)(Kf + i * XS + c0) = (f32x4){y[0], y[1], y[2], y[3]}; *(f32x4*)(Kf + i * XS + c0 + 4) = (f32x4){y[4], y[5], y[6], y[7]};
                } else {
                    *(f32x4*)(Vf + i * XS + c0) = (f32x4){y[0], y[1], y[2], y[3]}; *(f32x4*)(Vf + i * XS + c0 + 4) = (f32x4){y[4], y[5], y[6], y[7]};
                }
                x0 = x1; x1 = x2; x2 = x3;
            }
        }
        PREP_PREFETCH(it + itstep);
        __syncthreads();
#ifndef REP2
#define REP2 1
#endif
        for (int rep2 = 0; rep2 < REP2; ++rep2)
        {
            const int which = wid >> 2, ti = wid & 3, fr = lane & 15, fq = lane >> 4;
            const bf16_t* As = which ? Qn : Kn;
            bf16x8 af[4];
#pragma unroll
            for (int ks = 0; ks < 4; ++ks) af[ks] = *(const bf16x8*)(As + (ti * 16 + fr) * 136 + ks * 32 + fq * 8);
            bf16_t* attn = (bf16_t*)(R + 32768);
#pragma unroll
            for (int tj = 0; tj < 4; ++tj) {
                f32x4 acc = {0.f, 0.f, 0.f, 0.f};
#pragma unroll
                for (int ks = 0; ks < 4; ++ks) acc = mfma16(af[ks], *(const bf16x8*)(Kn + (tj * 16 + fr) * 136 + ks * 32 + fq * 8), acc);
                const int j = tj * 16 + fr; const float Gj = Gs[j];
#pragma unroll
                for (int r = 0; r < 4; ++r) {
                    const int i = ti * 16 + fq * 4 + r;
                    const float dec = (j <= i) ? __expf(Gs[i] - Gj) : 0.f;
                    if (which == 0) Am[j * 64 + i] = (j < i) ? Bs[i] * dec * acc[r] : 0.f;
                    else attn[i * 64 + kperm(j)] = f2bf(dec * acc[r]);
                }
            }
            if (which == 0 && lane < 16) {
                LDSWAIT();
                float t[16];
#pragma unroll
                for (int i = 0; i < 16; ++i) t[i] = (i == lane) ? 1.0f : 0.0f;
#pragma unroll
                for (int j = 0; j < 15; ++j) {
                    const float* ap = Am + (ti * 16 + j) * 64 + ti * 16;
#pragma unroll
                    for (int i = j + 1; i < 16; ++i) t[i] -= ap[i] * t[j];
                }
#pragma unroll
                for (int i = 0; i < 16; i += 4) *(f32x4*)(Td + ti * 256 + lane * 16 + i) = (f32x4){t[i], t[i + 1], t[i + 2], t[i + 3]};
            }
        }
        {
            const float Gl = Gs[63];
#pragma unroll
            for (int k = 0; k < 2; ++k) {
                const int q = tid + 512 * k, d = q & 127, ig = q >> 7;
                float v[8];
#pragma unroll
                for (int e = 0; e < 8; ++e) { const int i = ig * 8 + e; v[e] = Kf[i * XS + d] * __expf(Gl - Gs[i]); }
                u32x4 w; w.x = pk2(v[0], v[1]); w.y = pk2(v[2], v[3]); w.z = pk2(v[4], v[5]); w.w = pk2(v[6], v[7]);
                {   const int blk = (ig >> 2) * 32, m0 = (ig & 3) * 2; u32x2 wa, wb; wa.x = w.x; wa.y = w.y; wb.x = w.z; wb.y = w.w;
                    *(u32x2*)(R + 40960 + (d * 64 + blk + uperm(m0)) * 2) = wa; *(u32x2*)(R + 40960 + (d * 64 + blk + uperm(m0 + 1)) * 2) = wb; }
            }
        }
        __syncthreads();
        {
            int tl = tid0; asm volatile("" : "+v"(tl));
            const bool isU = wid < 4; float* X = isU ? Vf : Kf;
            const int c = tl & 15, g = (tl & 63) >> 4, colbase = (wid & 3) * 32;
#pragma unroll
            for (int kb = 0; kb < 4; ++kb) {
                f32x4 acc[2];
#pragma unroll
                for (int nt = 0; nt < 2; ++nt)
#pragma unroll
                    for (int r = 0; r < 4; ++r) { const int i = kb * 16 + 4 * g + r; acc[nt][r] = Bs[i] * (isU ? 1.0f : Es[i]) * X[i * XS + colbase + nt * 16 + c]; }
#pragma unroll
                for (int m = 0; m < kb; ++m)
#pragma unroll
                    for (int sx = 0; sx < 4; ++sx) {
                        const int kr = m * 16 + 4 * sx + g;
                        const float a = -Am[kr * 64 + kb * 16 + c];
#pragma unroll
                        for (int nt = 0; nt < 2; ++nt) acc[nt] = __builtin_amdgcn_mfma_f32_16x16x4f32(a, X[kr * XS + colbase + nt * 16 + c], acc[nt], 0, 0, 0);
                    }
#pragma unroll
                for (int nt = 0; nt < 2; ++nt)
#pragma unroll
                    for (int r = 0; r < 4; ++r) X[(kb * 16 + 4 * g + r) * XS + colbase + nt * 16 + c] = acc[nt][r];
                LDSWAIT();
                f32x4 xk[2];
                xk[0] = (f32x4){0.f, 0.f, 0.f, 0.f}; xk[1] = xk[0];
#pragma unroll
                for (int sx = 0; sx < 4; ++sx) {
                    const float a = Td[kb * 256 + (4 * sx + g) * 16 + c];
#pragma unroll
                    for (int nt = 0; nt < 2; ++nt) xk[nt] = __builtin_amdgcn_mfma_f32_16x16x4f32(a, X[(kb * 16 + 4 * sx + g) * XS + colbase + nt * 16 + c], xk[nt], 0, 0, 0);
                }
                LDSWAIT();
                if (kb < 3) {
#pragma unroll
                    for (int nt = 0; nt < 2; ++nt)
#pragma unroll
                        for (int r = 0; r < 4; ++r) X[(kb * 16 + 4 * g + r) * XS + colbase + nt * 16 + c] = xk[nt][r];
                    LDSWAIT();
                }
#pragma unroll
                for (int nt = 0; nt < 2; ++nt) {
                    const int col = colbase + nt * 16 + c;
                    if (isU) {
                        u32x2 w; w.x = pk2(xk[nt][0], xk[nt][1]); w.y = pk2(xk[nt][2], xk[nt][3]);
                        *(u32x2*)((bf16_t*)(R + 57344) + (((col >> 4) * 4 + kb) * 64 + lane) * 4) = w;
                    } else {
                        bf16_t* wn = (bf16_t*)R;
#pragma unroll
                        for (int r = 0; r < 4; ++r) wn[(kb * 16 + 4 * g + r) * 128 + kperm(col)] = f2bf(-xk[nt][r]);
                    }
                }
            }
        }
        if (late) asm volatile("s_waitcnt vmcnt(0)" ::: "memory");
        __syncthreads();
        if (late && tid == 0) {
            __builtin_amdgcn_fence(__ATOMIC_RELEASE, "agent"); asm volatile("s_waitcnt vmcnt(0)" ::: "memory");
            __hip_atomic_store(flags + ridx, 1u, __ATOMIC_RELAXED, __HIP_MEMORY_SCOPE_AGENT);
        }
    }
}

constexpr int SBUF = 62464;
__device__ __forceinline__ bf16x8 ldfrag(const unsigned char* base, int stride, int row, int kel, int g) {
    return *(const bf16x8*)(base + row * stride + (kel + 8 * g) * 2);
}
#define SC_LOAD(set, chunk) do { const unsigned char* _s = recb + (size_t)(chunk) * REC_BYTES; unsigned _vo = (unsigned)t2 * 16u; asm volatile("" : "+v"(_vo)); _Pragma("unroll") for (int _k = 0; _k < 14; ++_k) set[_k] = *(const u32x4*)(_s + _k * 4096 + _vo); } while (0)
#define SC_STORE(set, bufp) do { _Pragma("unroll") for (int _k = 0; _k < 14; ++_k) { const int _q = t2 + 256 * _k; int _o; \
        if (_k < 4) _o = (_q >> 4) * 272 + (_q & 15) * 16; else if (_k < 8) _o = 17408 + ((_q - 1024) >> 4) * 272 + (_q & 15) * 16; \
        else if (_k < 10) _o = 34816 + ((_q - 2048) >> 3) * 144 + (_q & 7) * 16; else _o = 44032 + ((_q - 2560) >> 3) * 144 + (_q & 7) * 16; \
        *(u32x4*)((bufp) + _o) = set[_k]; } } while (0)
__device__ __forceinline__ void gdn_scan(unsigned char* lds, const unsigned char* rec, const float* expgl, bf16_t* obuf, int tid, unsigned* flags) {
    const int bh = (blockIdx.x & 7) + 8 * (blockIdx.x >> 5), quarter = (blockIdx.x >> 3) & 3;
    const int lane = tid & 63, wid = tid >> 6;
    const unsigned char* recb = rec + (size_t)bh * NCH * REC_BYTES;
    if (wid >= 4) {
        const int t2 = tid - 256;
        u32x4 ra[14], rb[14];
        SC_LOAD(rb, 0); SC_STORE(rb, lds);
        SC_LOAD(ra, 1); SC_LOAD(rb, 2);
        __syncthreads();
        for (int n = 0; n < NCH; ++n) {
            unsigned char* nb = lds + ((n + 1) & 1) * SBUF;
            if (n & 1) { if (n + 1 < NCH) SC_STORE(rb, nb); if (n + 3 < NCH) SC_LOAD(rb, n + 3); }
            else       { if (n + 1 < NCH) SC_STORE(ra, nb); if (n + 3 < NCH) SC_LOAD(ra, n + 3); }
            if (wid == 4 && (n == NEARLY - 4 || n == NEARLY + 12)) {
                const int c = n + 4 + lane, cend = (n == NEARLY - 4) ? NEARLY + 16 : NCH;
                unsigned spins = 0;
                for (;;) {
                    const unsigned v = (c < cend) ? __hip_atomic_load(flags + bh * NCH + c, __ATOMIC_RELAXED, __HIP_MEMORY_SCOPE_AGENT) : 1u;
                    if (__all(v != 0u) || ++spins > (1u << 22)) break;
                    __builtin_amdgcn_s_sleep(8);
                }
                __builtin_amdgcn_fence(__ATOMIC_ACQUIRE, "agent");
                asm volatile("s_waitcnt vmcnt(0)" ::: "memory");
            }
            __syncthreads();
        }
    } else if (wid >= 2) {
        __syncthreads();
        for (int n = 0; n < NCH; ++n) __syncthreads();
    } else {
        const int fr = lane & 15, g = lane >> 4, slice = quarter * 2 + wid;
        f32x4 S[8]; bf16x8 Sb[4];
#pragma unroll
        for (int i = 0; i < 8; ++i) S[i] = (f32x4){0.f, 0.f, 0.f, 0.f};
#pragma unroll
        for (int i = 0; i < 4; ++i) Sb[i] = (bf16x8){0, 0, 0, 0, 0, 0, 0, 0};
        const float* ep = expgl + bh * NCH;
        float an = __hip_atomic_load(ep, __ATOMIC_RELAXED, __HIP_MEMORY_SCOPE_AGENT);
        u32x2 ubn[4];
        {   const u32x2* up = (const u32x2*)(recb + 57344) + (slice * 4) * 64 + lane;
#pragma unroll
            for (int rt = 0; rt < 4; ++rt) ubn[rt] = up[rt * 64]; }
        unsigned char* obb = (unsigned char*)(obuf + (size_t)bh * LP * 128);
        const unsigned ooff0 = (unsigned)((4 * g) * 128 + slice * 16 + fr) * 2u;
        __syncthreads();
        for (int n = 0; n < NCH; ++n) {
            const unsigned char* buf = lds + (n & 1) * SBUF;
            f32x4 ua[4], oa[4];
#pragma unroll
            for (int rt = 0; rt < 4; ++rt) { ua[rt] = (f32x4){bflo(ubn[rt].x), bfhi(ubn[rt].x), bflo(ubn[rt].y), bfhi(ubn[rt].y)}; oa[rt] = (f32x4){0.f, 0.f, 0.f, 0.f}; }
            const float a = an;
            if (n + 1 < NCH) { an = __hip_atomic_load(ep + n + 1, __ATOMIC_RELAXED, __HIP_MEMORY_SCOPE_AGENT);
                const u32x2* up = (const u32x2*)(recb + (size_t)(n + 1) * REC_BYTES + 57344) + (slice * 4) * 64 + lane;
#pragma unroll
                for (int rt = 0; rt < 4; ++rt) ubn[rt] = up[rt * 64]; }
#define SC_LDA(dst, rt_) do { _Pragma("unroll") for (int ks = 0; ks < 4; ++ks) { dst[ks] = ldfrag(buf, 272, (rt_) * 16 + fr, ks * 32, g); dst[4 + ks] = ldfrag(buf + 17408, 272, (rt_) * 16 + fr, ks * 32, g); } } while (0)
#define SC_MMA_A(src, rt_) do { _Pragma("unroll") for (int ks = 0; ks < 4; ++ks) { ua[rt_] = mfma16(src[ks], Sb[ks], ua[rt_]); oa[rt_] = mfma16(src[4 + ks], Sb[ks], oa[rt_]); } } while (0)
#define SC_SB() __builtin_amdgcn_sched_barrier(0)
            bf16x8 fA[8], fB[8];
            SC_LDA(fA, 0); SC_SB();
            SC_LDA(fB, 1); SC_SB(); SC_MMA_A(fA, 0); SC_SB();
            SC_LDA(fA, 2); SC_SB(); SC_MMA_A(fB, 1); SC_SB();
            SC_LDA(fB, 3); SC_SB(); SC_MMA_A(fA, 2); SC_SB();
#pragma unroll
            for (int rt = 0; rt < 4; ++rt) { fA[2 * rt] = ldfrag(buf + 34816, 144, rt * 16 + fr, 0, g); fA[2 * rt + 1] = ldfrag(buf + 34816, 144, rt * 16 + fr, 32, g); }
            SC_SB(); SC_MMA_A(fB, 3); SC_SB();
            bf16x8 ub2[2];
            ub2[0] = pack8(ua[0], ua[1]); ub2[1] = pack8(ua[2], ua[3]);
#pragma unroll
            for (int rt = 0; rt < 4; ++rt) { fB[2 * rt] = ldfrag(buf + 44032, 144, rt * 16 + fr, 0, g); fB[2 * rt + 1] = ldfrag(buf + 44032, 144, rt * 16 + fr, 32, g); }
            SC_SB();
#pragma unroll
            for (int rt = 0; rt < 4; ++rt) { oa[rt] = mfma16(fA[2 * rt], ub2[0], oa[rt]); oa[rt] = mfma16(fA[2 * rt + 1], ub2[1], oa[rt]); }
            SC_SB();
#pragma unroll
            for (int rt = 0; rt < 4; ++rt) { fA[2 * rt] = ldfrag(buf + 44032, 144, (4 + rt) * 16 + fr, 0, g); fA[2 * rt + 1] = ldfrag(buf + 44032, 144, (4 + rt) * 16 + fr, 32, g); }
            SC_SB();
#pragma unroll
            for (int rt = 0; rt < 4; ++rt) { f32x4 c = S[rt] * a; c = mfma16(fB[2 * rt], ub2[0], c); c = mfma16(fB[2 * rt + 1], ub2[1], c); S[rt] = c; }
            SC_SB();
#pragma unroll
            for (int rt = 0; rt < 4; ++rt) { f32x4 c = S[4 + rt] * a; c = mfma16(fA[2 * rt], ub2[0], c); c = mfma16(fA[2 * rt + 1], ub2[1], c); S[4 + rt] = c; }
#pragma unroll
            for (int ks = 0; ks < 4; ++ks) Sb[ks] = pack8(S[2 * ks], S[2 * ks + 1]);
            {   unsigned oo = ooff0 + (unsigned)n * 16384u; asm volatile("" : "+v"(oo));
#pragma unroll
                for (int rt = 0; rt < 4; ++rt)
#pragma unroll
                    for (int j = 0; j < 4; ++j) *(bf16_t*)(obb + (oo + (unsigned)(rt * 4096 + j * 256))) = f2bf(oa[rt][j]); }
            __syncthreads();
        }
    }
}

__device__ __forceinline__ void og_phase(const bf16_t* obuf, const bf16_t* gate, const float* onorm_g, bf16_t* og, int gw, int NGW, int lane) {
    const int hl = lane >> 4, dl = (lane & 15) * 8;
    float gn[8];
    { const f32x4 a = *(const f32x4*)(onorm_g + dl), b = *(const f32x4*)(onorm_g + dl + 4); gn[0] = a.x; gn[1] = a.y; gn[2] = a.z; gn[3] = a.w; gn[4] = b.x; gn[5] = b.y; gn[6] = b.z; gn[7] = b.w; }
    for (int r = gw; r < MROWS; r += NGW) {
        int b, p; if (r < MX) { b = r >> 13; p = (r & 8191) + NMETA; } else { b = (r - MX) >> 4; p = (r - MX) & 15; }
        const int pos = p + 48;
        u32x4 ov[2], gv[2];
#pragma unroll
        for (int q = 0; q < 2; ++q) {
            ov[q] = *(const u32x4*)(obuf + ((size_t)(b * 8 + 4 * q + hl) * LP + pos) * 128 + dl);
            gv[q] = *(const u32x4*)(gate + (size_t)r * 1024 + (4 * q + hl) * 128 + dl);
        }
#pragma unroll
        for (int q = 0; q < 2; ++q) {
            float o[8], gt[8];
            o[0] = bflo(ov[q].x); o[1] = bfhi(ov[q].x); o[2] = bflo(ov[q].y); o[3] = bfhi(ov[q].y); o[4] = bflo(ov[q].z); o[5] = bfhi(ov[q].z); o[6] = bflo(ov[q].w); o[7] = bfhi(ov[q].w);
            gt[0] = bflo(gv[q].x); gt[1] = bfhi(gv[q].x); gt[2] = bflo(gv[q].y); gt[3] = bfhi(gv[q].y); gt[4] = bflo(gv[q].z); gt[5] = bfhi(gv[q].z); gt[6] = bflo(gv[q].w); gt[7] = bfhi(gv[q].w);
            float ss = 0.f;
#pragma unroll
            for (int e = 0; e < 8; ++e) ss += o[e] * o[e];
            ss += __shfl_xor(ss, 1); ss += __shfl_xor(ss, 2); ss += __shfl_xor(ss, 4); ss += __shfl_xor(ss, 8);
            const float rinv = rsqrtf(ss * (1.0f / 128.0f) + EPS);
            float v[8];
#pragma unroll
            for (int e = 0; e < 8; ++e) v[e] = o[e] * rinv * gn[e] * siluf(gt[e]);
            u32x4 w; w.x = pk2(v[0], v[1]); w.y = pk2(v[2], v[3]); w.z = pk2(v[4], v[5]); w.w = pk2(v[6], v[7]);
            *(u32x4*)(og + (size_t)r * 1024 + (4 * q + hl) * 128 + dl) = w;
        }
    }
}

__device__ __forceinline__ void attn_phase(const bf16_t* qk, const bf16_t* vt, bf16_t* og, int gw, int NGW, int lane) {
    constexpr int NQB = (LSEQ + 31) / 32;
    const int ql = lane & 31, hh = lane >> 5;
    for (int it = gw; it < NB * 16 * NQB; it += NGW) {
        const int qb = it < NB * 16 * (NQB - 1) ? 1 + it % (NQB - 1) : 0, bh = it < NB * 16 * (NQB - 1) ? it / (NQB - 1) : it - NB * 16 * (NQB - 1), b = bh >> 4, h = bh & 15;
        const int qpos = qb * 32 + ql;
        bf16x8 qf[4];
        {   const bf16_t* qp = qk + (size_t)rowof(b, min(qpos, LSEQ - 1)) * 2048 + h * 64 + 8 * hh;
#pragma unroll
            for (int ks = 0; ks < 4; ++ks) qf[ks] = *(const bf16x8*)(qp + 16 * ks); }
        f32x16 o0, o1;
#pragma unroll
        for (int e = 0; e < 16; ++e) { o0[e] = 0.f; o1[e] = 0.f; }
        float R = 0.f;
        const bf16_t* vbase = vt + (size_t)bh * 64 * LP;
        for (int kb = qb; kb >= 0; --kb) {
            const bf16_t* kp = qk + (size_t)rowof(b, min(kb * 32 + ql, LSEQ - 1)) * 2048 + 1024 + h * 64 + 8 * hh;
            f32x16 z;
#pragma unroll
            for (int e = 0; e < 16; ++e) z[e] = 0.f;
#pragma unroll
            for (int ks = 0; ks < 4; ++ks) z = mfma32(*(const bf16x8*)(kp + 16 * ks), qf[ks], z);
            bf16x8 vb[2][2];
#pragma unroll
            for (int s = 0; s < 2; ++s)
#pragma unroll
                for (int dt = 0; dt < 2; ++dt) {
                    const bf16_t* vp = vbase + ((size_t)kb * 64 + ql + 32 * dt) * 32 + 16 * s + 4 * hh;
                    const u32x2 lo = *(const u32x2*)vp, hi = *(const u32x2*)(vp + 8);
                    u32x4 v; v.x = lo.x; v.y = lo.y; v.z = hi.x; v.w = hi.y; vb[s][dt] = as_bf16x8(v);
                }
            float lb[16], lk[16];
            if (kb == qb) {
#pragma unroll
                for (int e = 0; e < 16; ++e) {
                    const int key = kb * 32 + (e & 3) + 8 * (e >> 2) + 4 * hh;
                    const float zz = z[e] * 0.18033688011112042f;
                    const float sp = __builtin_amdgcn_logf(1.0f + __builtin_amdgcn_exp2f(-fabsf(zz)));
                    const bool vis = key < qpos;
                    const float l = fminf(zz, 0.f) - sp;
                    lb[e] = vis ? l : -1e30f;
                    lk[e] = vis ? l - zz : 0.f;
                }
            } else {
#pragma unroll
                for (int e = 0; e < 16; ++e) {
                    const float zz = z[e] * 0.18033688011112042f;
                    const float sp = __builtin_amdgcn_logf(1.0f + __builtin_amdgcn_exp2f(-fabsf(zz)));
                    lb[e] = fminf(zz, 0.f) - sp;
                    lk[e] = lb[e] - zz;
                }
            }
            float gs[4], pg[4];
#pragma unroll
            for (int m = 0; m < 4; ++m) gs[m] = (lk[4 * m] + lk[4 * m + 1]) + (lk[4 * m + 2] + lk[4 * m + 3]);
#pragma unroll
            for (int m = 0; m < 4; ++m) pg[m] = __shfl_xor(gs[m], 32);
            float w[16];
            float later = R;
#pragma unroll
            for (int m = 3; m >= 0; --m) {
                const float lat = later + (hh == 0 ? pg[m] : 0.f);
                const float s3 = lat, s2 = s3 + lk[4 * m + 3], s1 = s2 + lk[4 * m + 2], s0 = s1 + lk[4 * m + 1];
                w[4 * m + 3] = __builtin_amdgcn_exp2f(lb[4 * m + 3] + s3); w[4 * m + 2] = __builtin_amdgcn_exp2f(lb[4 * m + 2] + s2);
                w[4 * m + 1] = __builtin_amdgcn_exp2f(lb[4 * m + 1] + s1); w[4 * m] = __builtin_amdgcn_exp2f(lb[4 * m] + s0);
                later += gs[m] + pg[m];
            }
            R = later;
            u32x4 p0, p1;
            p0.x = pk2(w[0], w[1]); p0.y = pk2(w[2], w[3]); p0.z = pk2(w[4], w[5]); p0.w = pk2(w[6], w[7]);
            p1.x = pk2(w[8], w[9]); p1.y = pk2(w[10], w[11]); p1.z = pk2(w[12], w[13]); p1.w = pk2(w[14], w[15]);
            const bf16x8 pa0 = as_bf16x8(p0), pa1 = as_bf16x8(p1);
            o0 = mfma32(pa0, vb[0][0], o0); o0 = mfma32(pa1, vb[1][0], o0);
            o1 = mfma32(pa0, vb[0][1], o1); o1 = mfma32(pa1, vb[1][1], o1);
            if (__all(R < -160.0f)) break;
        }
#pragma unroll
        for (int e = 0; e < 16; ++e) {
            const int qp2 = qb * 32 + (e & 3) + 8 * (e >> 2) + 4 * hh;
            if (qp2 < LSEQ) { bf16_t* op = og + (size_t)rowof(b, qp2) * 1024 + h * 64 + ql; op[0] = f2bf(o0[e]); op[32] = f2bf(o1[e]); }
        }
    }
}

#define LAS __attribute__((address_space(3)))
#define XB_TMO      128
#define XB_XCNT(j)  (256  + 64 * (j))
#define XB_XSUB(j)  (1280 + 64 * (j))
#define XB_XGEN(j)  (2304 + 64 * (j))
#define XB_TOP      3328
#define XB_TOPGEN   3392
#define XCD_BAR_WORDS 3456
#define XB_SPIN_CAP (1u << 18)

__device__ __forceinline__ unsigned xb_ld(unsigned* p)              { return __hip_atomic_load(p, __ATOMIC_RELAXED, __HIP_MEMORY_SCOPE_AGENT); }
__device__ __forceinline__ unsigned xb_add(unsigned* p, unsigned v) { return __hip_atomic_fetch_add(p, v, __ATOMIC_RELAXED, __HIP_MEMORY_SCOPE_AGENT); }
__device__ __forceinline__ unsigned xb_xcc_id() { return (unsigned)__builtin_amdgcn_s_getreg((3 << 11) | 20) & 0xFu; }
#define XB_SPIN(cond, bar) do { unsigned _sp = 0; while (cond) { __builtin_amdgcn_s_sleep(1); \
    if ((++_sp & 255u) == 0u) { if (xb_ld(&(bar)[XB_TMO])) break; if (_sp > XB_SPIN_CAP) { atomicAdd(&(bar)[XB_TMO], 1u); break; } } } } while (0)

struct XcdBarrier {
    unsigned* bar; unsigned x;
    volatile LAS unsigned* st;
};

__device__ __forceinline__ XcdBarrier xcd_barrier_post(unsigned* bar, volatile LAS unsigned* st) {
    XcdBarrier b; b.bar = bar; b.x = xb_xcc_id(); b.st = st;
    if (threadIdx.x == 0) (void)xb_add(&bar[XB_XCNT(b.x)], 1u);
    return b;
}
__device__ __forceinline__ void xcd_barrier_complete(unsigned* bar, unsigned x, unsigned& nloc, unsigned& nx) {
    const unsigned G = gridDim.x * gridDim.y * gridDim.z;
    unsigned sum, cnt, mine, sp = 0u;
    for (;;) {
        sum = 0u; cnt = 0u; mine = 0u;
#pragma unroll
        for (unsigned j = 0; j < 16; ++j) { const unsigned c = xb_ld(&bar[XB_XCNT(j)]); sum += c; cnt += (c > 0u) ? 1u : 0u; mine = (j == x) ? c : mine; }
        if (sum == G) break;
        __builtin_amdgcn_s_sleep(1);
        if ((++sp & 255u) == 0u) { if (xb_ld(&bar[XB_TMO])) break; if (sp > XB_SPIN_CAP) { atomicAdd(&bar[XB_TMO], 1u); break; } }
    }
    nloc = mine > 0u ? mine : 1u; nx = cnt > 0u ? cnt : 1u;
}

__device__ __forceinline__ void xcd_barrier(const XcdBarrier& b) {
    asm volatile("s_waitcnt vmcnt(0)" ::: "memory");
    __syncthreads();
    if (threadIdx.x == 0) {
        unsigned* bar = b.bar;
        __builtin_amdgcn_s_waitcnt(0);
        unsigned nloc = b.st[0], nx = b.st[1];
        if (nloc == 0u) { xcd_barrier_complete(bar, b.x, nloc, nx); b.st[0] = nloc; b.st[1] = nx; }
        const unsigned old = xb_add(&bar[XB_XSUB(b.x)], 1u);
        const unsigned gen = old / nloc;
        if (old + 1u == (gen + 1u) * nloc) {
            __builtin_amdgcn_fence(__ATOMIC_RELEASE, "agent");
            asm volatile("s_waitcnt vmcnt(0)" ::: "memory");
            const unsigned og = xb_add(&bar[XB_TOP], 1u);
            const unsigned tg = og / nx;
            if (og + 1u == (tg + 1u) * nx) xb_add(&bar[XB_TOPGEN], 1u);
            else XB_SPIN(xb_ld(&bar[XB_TOPGEN]) == tg, bar);
            __builtin_amdgcn_fence(__ATOMIC_ACQUIRE, "agent");
            xb_add(&bar[XB_XGEN(b.x)], 1u);
            asm volatile("s_waitcnt vmcnt(0)" ::: "memory");
        } else {
            XB_SPIN(xb_ld(&bar[XB_XGEN(b.x)]) == gen, bar);
            __builtin_amdgcn_fence(__ATOMIC_ACQUIRE, "agent");
            asm volatile("s_waitcnt vmcnt(0)" ::: "memory");
        }
    }
    __syncthreads();
}


struct Params { const float* in[18]; float* out; unsigned char* ws; };
#define BAR_ALL() do { asm volatile("s_waitcnt vmcnt(0) lgkmcnt(0)" ::: "memory"); __syncthreads(); } while (0)
#define PH_BEGIN() \
    int tid = threadIdx.x; asm volatile("" : "+v"(tid)); \
    const int lane = tid & 63, wid = __builtin_amdgcn_readfirstlane(tid >> 6), gw = blockIdx.x * 8 + wid; (void)lane; (void)gw; \
    size_t zoff = 0; asm volatile("" : "+s"(zoff)); \
    unsigned char* ws = P.ws + zoff; float* dout = (float*)((unsigned char*)P.out + zoff); \
    bf16_t* WIN = (bf16_t*)(ws + WS_WIN); unsigned char* REC = ws + WS_REC; bf16_t* HN = (bf16_t*)(ws + WS_REC); bf16_t* ACT = (bf16_t*)(ws + WS_REC + HN_BYTES); \
    bf16_t* QKVPRE = (bf16_t*)(ws + WS_R4); bf16_t* GATE = (bf16_t*)dout; float* AB = (float*)((unsigned char*)dout + HN_BYTES); \
    float* HMETA = (float*)(ws + WS_HMETA); float* EXPGL = (float*)(ws + WS_EXPGL); float* scr = (float*)(lds + wid * 8448); \
    (void)WIN; (void)REC; (void)HN; (void)ACT; (void)QKVPRE; (void)GATE; (void)AB; (void)HMETA; (void)EXPGL; (void)scr;
#define SEAM() do { XcdBarrier xb; xb.bar = (unsigned*)(P.ws + WS_BAR); xb.x = xb_xcc_id(); xb.st = (volatile LAS unsigned*)(lds + 131072); xcd_barrier(xb); } while (0)

template <int MODE> __device__ __forceinline__ void gemm_full(unsigned char* lds, int G, const bf16_t* A, const bf16_t* Bt, int N, int K, bf16_t* o0, bf16_t* o1, bf16_t* vt,
                                                              const float* res, float* outf, float* tab, const float* tres, float* hmeta, int tid) {
    const pg8::Gemm g{A, Bt, MX, N, K};
    const EpiUni<MODE> E{o0, o1, vt, res, outf};
    pg8::StaticOrder S; S.init(MX, N, G, (int)blockIdx.x);
#ifndef GEMM_ALIGN
#define GEMM_ALIGN true
#endif
#ifndef GEMM_SP2
#define GEMM_SP2 true
#endif
    pg8::gemm_phase<EpiUni<MODE>, pg8::StaticOrder, GEMM_ALIGN, GEMM_SP2>((PG8_LAS unsigned char*)lds, g, S, E);
    const TailP T{A, Bt, K, o0, o1, vt, tab, tres, hmeta};
    tail_gemm<MODE>(T, lds, tid);
}

__global__ void __launch_bounds__(512, 2) fwd_mega(Params P) {
    extern __shared__ __attribute__((aligned(16))) unsigned char lds[];
    cg::grid_group grid = cg::this_grid();
    const int G = gridDim.x, NGW = G * 8;
    if (threadIdx.x < 4) ((unsigned*)(lds + 131072))[threadIdx.x] = 0u;
    __syncthreads();
    (void)xcd_barrier_post((unsigned*)(P.ws + WS_BAR), (volatile LAS unsigned*)(lds + 131072));
    if (G == 0x7fffffff) grid.sync();

    {   PH_BEGIN();
        for (int it = gw; it < 16 * 136; it += NGW) transpose_item(P.in[3], 1024, 4112, 136, P.in[2], WIN, 0, scr, it, lane);
        {   const float* x_ = P.in[0]; const float* m_ = P.in[1];
            rms_rows_bf16([=](int r) { return r < MX ? x_ + (size_t)r * D : m_ + (size_t)((r - MX) & 15) * D; }, HN, MROWS, gw, NGW, lane); }
    }
    SEAM();
    {   PH_BEGIN();
        gemm_full<EM_PROJ>(lds, G, HN, WIN, 4096, 1024, QKVPRE, GATE, nullptr, nullptr, nullptr, AB, nullptr, HMETA, tid);
    }
    SEAM();
    {   PH_BEGIN();
        gdn_prep(lds, QKVPRE, AB, P.in[4], P.in[5], P.in[6], REC, EXPGL, tid, (int)blockIdx.x, NEARLY * 16, G, false, nullptr);
    }
    SEAM();
    {   PH_BEGIN();
        unsigned* FLAGS = (unsigned*)(ws + WS_FLAGS);
        if (blockIdx.x < 64) gdn_scan(lds, REC, EXPGL, QKVPRE  , tid, FLAGS);
        else {
            gdn_prep(lds, QKVPRE, AB, P.in[4], P.in[5], P.in[6], REC, EXPGL, tid, (int)blockIdx.x - 64, (NCH - NEARLY) * 16, G - 64, true, FLAGS);
            const int gw2 = (blockIdx.x - 64) * 8 + wid, NGW2 = (G - 64) * 8;
            for (int it = gw2; it < 11008; it += NGW2) {
                int r = it; const float* W; const float* gn = nullptr; int K = 1024, N = 1024, nblk = 32, mp = 0; size_t dst;
                if (r < 512) { W = P.in[8]; dst = W_OUT; }
                else if ((r -= 512) < 2816) { W = P.in[15]; N = 5632; nblk = 176; gn = P.in[14]; mp = 1; dst = W_GU0; }
                else if ((r -= 2816) < 1408) { W = P.in[16]; K = 2816; dst = W_D0; }
                else if ((r -= 1408) < 512) { W = P.in[12]; gn = P.in[11]; dst = W_QKV; }
                else if ((r -= 512) < 1024) { W = P.in[10]; N = 2048; nblk = 64; gn = P.in[9]; dst = W_QKV + (size_t)1024 * 1024 * 2; }
                else if ((r -= 1024) < 512) { W = P.in[13]; dst = W_O; }
                else if ((r -= 512) < 2816) { W = P.in[15] + (size_t)1024 * 5632; N = 5632; nblk = 176; gn = P.in[14] + 1024; mp = 1; dst = W_GU1; }
                else { r -= 2816; W = P.in[16] + (size_t)2816 * 1024; K = 2816; dst = W_D1; }
                transpose_item(W, K, N, nblk, gn, (bf16_t*)(ws + dst), mp, scr, r, lane);
            }
        }
    }
    SEAM();
    {   PH_BEGIN();
        og_phase(QKVPRE  , GATE, P.in[7], HN  , gw, NGW, lane);
    }
    SEAM();
    {   PH_BEGIN();
        gemm_full<EM_RES>(lds, G, HN, (const bf16_t*)(ws + W_OUT), 1024, 1024, nullptr, nullptr, nullptr, P.in[0], (float*)ws, nullptr, P.in[1], HMETA, tid);
    }
    SEAM();
#define NORM_PHASE() { PH_BEGIN(); rms_rows_h16(ws, HMETA, HN, gw, NGW, lane); }
    NORM_PHASE();
    SEAM();
    {   PH_BEGIN();
        gemm_full<EM_SWIGLU>(lds, G, HN, (const bf16_t*)(ws + W_GU0), 5632, 1024, ACT, nullptr, nullptr, nullptr, nullptr, nullptr, nullptr, HMETA, tid);
    }
    SEAM();
    {   PH_BEGIN();
        gemm_full<EM_RES>(lds, G, ACT, (const bf16_t*)(ws + W_D0), 1024, 2816, nullptr, nullptr, nullptr, nullptr, (float*)ws, nullptr, HMETA, HMETA, tid);
    }
    SEAM();
    NORM_PHASE();
    SEAM();
    {   PH_BEGIN();
        for (int i = blockIdx.x * 512 + tid; i < 32 * 64 * 16; i += G * 512) QKVPRE[vt_index(i >> 10, (i >> 4) & 63, LSEQ + (i & 15))] = 0;
        gemm_full<EM_QKV>(lds, G, HN, (const bf16_t*)(ws + W_QKV), 3072, 1024, ACT  , nullptr, QKVPRE  , nullptr, nullptr, nullptr, nullptr, HMETA, tid);
    }
    SEAM();
    {   PH_BEGIN();
        attn_phase(ACT  , QKVPRE  , HN  , gw, NGW, lane);
    }
    SEAM();
    {   PH_BEGIN();
        gemm_full<EM_RES>(lds, G, HN, (const bf16_t*)(ws + W_O), 1024, 1024, nullptr, nullptr, nullptr, nullptr, (float*)ws, nullptr, HMETA, HMETA, tid);
    }
    SEAM();
    NORM_PHASE();
    SEAM();
    {   PH_BEGIN();
        gemm_full<EM_SWIGLU>(lds, G, HN, (const bf16_t*)(ws + W_GU1), 5632, 1024, ACT, nullptr, nullptr, nullptr, nullptr, nullptr, nullptr, HMETA, tid);
    }
    SEAM();
    {   PH_BEGIN();
        gemm_full<EM_RES>(lds, G, ACT, (const bf16_t*)(ws + W_D1), 1024, 2816, nullptr, nullptr, nullptr, nullptr, (float*)ws, nullptr, HMETA, HMETA, tid);
    }
    SEAM();
    {   PH_BEGIN();
        const f32x4* gp = (const f32x4*)P.in[17] + lane;
        f32x4 gv[4]; u32x2 v[4], nv[4];
#pragma unroll
        for (int j = 0; j < 4; ++j) gv[j] = gp[64 * j];
        int r = gw;
        if (r < MX) { const u32x2* s = (const u32x2*)h16row(ws, r) + lane;
#pragma unroll
            for (int j = 0; j < 4; ++j) v[j] = s[64 * j]; }
        for (; r < MX; r += NGW) {
            if (r + NGW < MX) { const u32x2* s = (const u32x2*)h16row(ws, r + NGW) + lane;
#pragma unroll
                for (int j = 0; j < 4; ++j) nv[j] = s[64 * j]; }
            f32x4 f[4]; float ss = 0.f;
#pragma unroll
            for (int j = 0; j < 4; ++j) { f[j] = (f32x4){bflo(v[j].x), bfhi(v[j].x), bflo(v[j].y), bfhi(v[j].y)}; ss += (f[j].x * f[j].x + f[j].y * f[j].y) + (f[j].z * f[j].z + f[j].w * f[j].w); }
            const float rr = rsqrtf(wave_sum(ss) * (1.0f / 1024.0f) + EPS);
            f32x4* o = (f32x4*)(dout + (size_t)r * D) + lane;
#pragma unroll
            for (int j = 0; j < 4; ++j) o[64 * j] = f[j] * rr * gv[j];
#pragma unroll
            for (int j = 0; j < 4; ++j) v[j] = nv[j];
        }
    }
}

extern "C" void kernel_launch(void* const* d_in, const int* in_sizes, int n_in, void* d_out, int out_size, void* d_ws, size_t ws_size, hipStream_t stream) {
    static int grid_blocks = 0;
    if (grid_blocks == 0) {
        if (n_in != 18 || ws_size < WS_END) { fprintf(stderr, "kernel_launch: unexpected n_in %d / ws_size %zu (need %zu)\n", n_in, ws_size, (size_t)WS_END); grid_blocks = -1; return; }
        int dev = 0, cus = 0, per_cu = 0;
        hipGetDevice(&dev);
        hipDeviceGetAttribute(&cus, hipDeviceAttributeMultiprocessorCount, dev);
        if (hipFuncSetAttribute((const void*)fwd_mega, hipFuncAttributeMaxDynamicSharedMemorySize, LDS_BYTES) != hipSuccess) { fprintf(stderr, "kernel_launch: hipFuncSetAttribute failed\n"); grid_blocks = -1; return; }
        hipOccupancyMaxActiveBlocksPerMultiprocessor(&per_cu, (const void*)fwd_mega, 512, LDS_BYTES);
        if (per_cu < 1) { fprintf(stderr, "kernel_launch: occupancy query gave %d\n", per_cu); per_cu = 1; }
        grid_blocks = cus;
        if (grid_blocks < 128) { fprintf(stderr, "kernel_launch: only %d CUs\n", grid_blocks); grid_blocks = -1; return; }
    }
    if (grid_blocks < 0) return;
    if (hipMemsetAsync((unsigned char*)d_ws + WS_BAR, 0, 16384 + 8448, stream) != hipSuccess) { fprintf(stderr, "kernel_launch: memset of barrier words failed\n"); return; }
    Params p{};
    for (int i = 0; i < 18; ++i) p.in[i] = (const float*)d_in[i];
    p.out = (float*)d_out; p.ws = (unsigned char*)d_ws;
    void* args[] = {&p};
    hipError_t e = hipLaunchCooperativeKernel((const void*)fwd_mega, dim3(grid_blocks), dim3(512), args, LDS_BYTES, stream);
    if (e != hipSuccess) fprintf(stderr, "cooperative launch failed: %s (grid %d)\n", hipGetErrorString(e), grid_blocks);
}
```
